# Optimizing an MI355X kernel written in HIP

```python
import jax, jax.numpy as jnp
from jax import lax
import numpy as np

D_MODEL = 2048
BATCH = 8
SEQ = 2048
DEPTH = 2

GRID_W = 64
CTX_LEN = 256
EPS = 1e-6
NEG_INF = -1e30
HEAD_DIM = 128
A_Q_HEADS = (D_MODEL // 2) // HEAD_DIM
A_KV_HEADS = 2
A_GROUP = A_Q_HEADS // A_KV_HEADS
WINDOW = 128
BLOCK_Q = 128
ROPE_BASE = 10000.0
B_HEADS = 4
B_DV = (D_MODEL // 2) // B_HEADS
B_DK = B_DV // 2
B_GATE_RANK = 16
B_GATE_NORM = 16.0
B_CHUNK = 64
C_GROUPS = 8
C_GROUP_DIM = D_MODEL // C_GROUPS
D_FF = 4 * D_MODEL

N_EVEN = (DEPTH + 1) // 2
N_ODD = DEPTH // 2
A_Q_W = A_Q_HEADS * HEAD_DIM
A_KV_W = A_KV_HEADS * HEAD_DIM
B_QK_W = B_HEADS * B_DK
B_V_W = B_HEADS * B_DV
IN_SPLITS = (A_Q_W, A_KV_W, A_KV_W, B_QK_W, B_QK_W, B_V_W, B_V_W, B_GATE_RANK, B_GATE_RANK)
IN_COLS = sum(IN_SPLITS)
MIX_OUT = A_Q_W + B_V_W

kernel_name = "hybrid_dit_window_gla_fourier"


def rms_norm(x, g):
    xf = x.astype(jnp.float32)
    y = xf * lax.rsqrt(jnp.mean(xf * xf, axis=-1, keepdims=True) + EPS)
    return (y * g.astype(jnp.float32)).astype(x.dtype)


def modulate(h, shift, scale):
    return h * (1 + scale) + shift


def heads(t, n):
    b, l, _ = t.shape
    return t.reshape(b, l, n, -1).transpose(0, 2, 1, 3)


def merge_heads(t):
    b, n, l, d = t.shape
    return t.transpose(0, 2, 1, 3).reshape(b, l, n * d)


def flip(t):
    return t[:, :, ::-1]


def axial_rope_angles(n_rows):
    row = jnp.repeat(jnp.arange(n_rows), GRID_W).astype(jnp.float32)
    col = jnp.tile(jnp.arange(GRID_W), n_rows).astype(jnp.float32)
    n_freq = HEAD_DIM // 4
    inv_freq = ROPE_BASE ** (-jnp.arange(n_freq, dtype=jnp.float32) / n_freq)
    return row[:, None] * inv_freq, col[:, None] * inv_freq


def rope_1d(x, ang):
    n = ang.shape[-1]
    cos, sin = jnp.cos(ang).astype(x.dtype), jnp.sin(ang).astype(x.dtype)
    x1, x2 = x[..., :n], x[..., n:]
    return jnp.concatenate([x1 * cos - x2 * sin, x2 * cos + x1 * sin], axis=-1)


def apply_axial_rope(x, ang_r, ang_c):
    half = HEAD_DIM // 2
    return jnp.concatenate([rope_1d(x[..., :half], ang_r), rope_1d(x[..., half:], ang_c)], axis=-1)


def ab_project(h, w_in, q_norm, k_norm, gk_f, gk_f_b, gk_b, gk_b_b):
    parts = jnp.split(h @ w_in, np.cumsum(IN_SPLITS)[:-1].tolist(), axis=-1)
    aq, ak, av, bq, bk, bv, bgate, lr_f, lr_b = parts
    aq = rms_norm(heads(aq, A_Q_HEADS), q_norm)
    ak = rms_norm(heads(ak, A_KV_HEADS), k_norm)
    av = heads(av, A_KV_HEADS)

    def log_decay(lr, w, b):
        return jax.nn.log_sigmoid((lr @ w + b).astype(jnp.float32)) / B_GATE_NORM

    gf = heads(log_decay(lr_f, gk_f, gk_f_b), B_HEADS)
    gb = heads(log_decay(lr_b, gk_b, gk_b_b), B_HEADS)
    bq = heads(bq.astype(jnp.float32), B_HEADS) * B_DK ** -0.5
    bk = heads(bk.astype(jnp.float32), B_HEADS)
    bv = heads(bv.astype(jnp.float32), B_HEADS)
    return aq, ak, av, bq, bk, bv, gf, gb, bgate


def window_attention(q, k, v, kc, vc, sink):
    bsz, _, n_lat, d = q.shape
    nb = n_lat // BLOCK_Q
    qb = q.reshape(bsz, A_KV_HEADS, A_GROUP, nb, BLOCK_Q, d)
    pad = ((0, 0), (0, 0), (BLOCK_Q, BLOCK_Q), (0, 0))
    kp = jnp.pad(k, pad).reshape(bsz, A_KV_HEADS, nb + 2, BLOCK_Q, d)
    vp = jnp.pad(v, pad).reshape(bsz, A_KV_HEADS, nb + 2, BLOCK_Q, d)

    def band(t):
        return jnp.concatenate([t[:, :, :-2], t[:, :, 1:-1], t[:, :, 2:]], axis=3)

    kw, vw = band(kp), band(vp)
    scale = d ** -0.5
    s_lat = jnp.einsum("bkgnqd,bknsd->bkgnqs", qb, kw, preferred_element_type=jnp.float32) * scale
    s_ctx = jnp.einsum("bkgnqd,bkcd->bkgnqc", qb, kc, preferred_element_type=jnp.float32) * scale
    blk = jnp.arange(nb)[:, None, None]
    qpos = blk * BLOCK_Q + jnp.arange(BLOCK_Q)[None, :, None]
    kpos = (blk - 1) * BLOCK_Q + jnp.arange(3 * BLOCK_Q)[None, None, :]
    valid = (jnp.abs(qpos - kpos) <= WINDOW) & (kpos >= 0) & (kpos < n_lat)
    s_lat = jnp.where(valid, s_lat, NEG_INF)
    s_sink = jnp.broadcast_to(sink.astype(jnp.float32).reshape(A_KV_HEADS, A_GROUP, 1, 1, 1),
                              s_lat.shape[:-1] + (1,))
    p = jax.nn.softmax(jnp.concatenate([s_lat, s_ctx, s_sink], axis=-1), axis=-1).astype(v.dtype)
    n_w = 3 * BLOCK_Q
    n_ctx = kc.shape[2]
    o = (jnp.einsum("bkgnqs,bknsd->bkgnqd", p[..., :n_w], vw)
         + jnp.einsum("bkgnqc,bkcd->bkgnqd", p[..., n_w:n_w + n_ctx], vc))
    return o.reshape(bsz, A_Q_HEADS, n_lat, d)


def context_attention(qc, kc, vc, sink):
    bsz, _, n_ctx, d = qc.shape
    qg = qc.reshape(bsz, A_KV_HEADS, A_GROUP, n_ctx, d)
    s = jnp.einsum("bkgqd,bkcd->bkgqc", qg, kc, preferred_element_type=jnp.float32) * d ** -0.5
    s_sink = jnp.broadcast_to(sink.astype(jnp.float32).reshape(A_KV_HEADS, A_GROUP, 1, 1), s.shape[:-1] + (1,))
    p = jax.nn.softmax(jnp.concatenate([s, s_sink], axis=-1), axis=-1)[..., :n_ctx].astype(vc.dtype)
    o = jnp.einsum("bkgqc,bkcd->bkgqd", p, vc)
    return o.reshape(bsz, A_Q_HEADS, n_ctx, d)


def gla_chunked(q, k, v, g, s0):
    bsz, nh, n_tok, dk = q.shape
    dv = v.shape[-1]
    n = n_tok // B_CHUNK

    def rs(t):
        return t.reshape(bsz, nh, n, B_CHUNK, t.shape[-1])

    q, k, v, g = rs(q), rs(k), rs(v), rs(g)
    b = jnp.cumsum(g, axis=3)
    b_last = b[:, :, :, -1:]
    qe = q * jnp.exp(b)
    ke = k * jnp.exp(-b)
    kd = k * jnp.exp(b_last - b)
    causal = jnp.tril(jnp.ones((B_CHUNK, B_CHUNK), dtype=bool))
    a = jnp.where(causal, jnp.einsum("bhncd,bhnsd->bhncs", qe, ke), 0.0)
    o_intra = jnp.einsum("bhncs,bhnse->bhnce", a, v)

    def step(state, xs):
        qe_c, kd_c, v_c, dec = xs
        o = jnp.einsum("bhcd,bhde->bhce", qe_c, state)
        state = dec[..., None] * state + jnp.einsum("bhcd,bhce->bhde", kd_c, v_c)
        return state, o

    xs = (jnp.moveaxis(qe, 2, 0), jnp.moveaxis(kd, 2, 0), jnp.moveaxis(v, 2, 0),
          jnp.moveaxis(jnp.exp(b[:, :, :, -1]), 2, 0))
    s_fin, o_inter = lax.scan(step, s0, xs)
    o = o_intra + jnp.moveaxis(o_inter, 0, 2)
    return o.reshape(bsz, nh, n_tok, dv), s_fin


def gla_final_state(k, v, g):
    b = jnp.cumsum(g, axis=2)
    return jnp.einsum("bhtd,bhte->bhde", k * jnp.exp(b[:, :, -1:] - b), v)


def ab_output(o_a, o_b, gate, gla_norm, w_out):
    o_b = merge_heads(rms_norm(o_b, gla_norm)).astype(gate.dtype) * jax.nn.silu(gate)
    return jnp.concatenate([merge_heads(o_a), o_b], axis=-1) @ w_out


def ab_mixer(h, hc, need_ctx_out, w_in, q_norm, k_norm, sink, gk_f, gk_f_b, gk_b, gk_b_b,
             gla_norm, w_out, ang_r, ang_c):
    aq, ak, av, bq, bk, bv, gf, gb, bgate = ab_project(h, w_in, q_norm, k_norm, gk_f, gk_f_b, gk_b, gk_b_b)
    cq, ck, cv, cbq, cbk, cbv, cgf, cgb, cgate = ab_project(hc, w_in, q_norm, k_norm, gk_f, gk_f_b, gk_b, gk_b_b)
    aq = apply_axial_rope(aq, ang_r, ang_c)
    ak = apply_axial_rope(ak, ang_r, ang_c)
    o_a = window_attention(aq, ak, av, ck, cv, sink)
    yc = None
    if need_ctx_out:
        zero = jnp.zeros((hc.shape[0], B_HEADS, B_DK, B_DV), jnp.float32)
        oc_f, s_f = gla_chunked(cbq, cbk, cbv, cgf, zero)
        oc_b, s_b = gla_chunked(flip(cbq), flip(cbk), flip(cbv), flip(cgb), zero)
        oc_a = context_attention(cq, ck, cv, sink)
        yc = ab_output(oc_a, oc_f + flip(oc_b), cgate, gla_norm, w_out)
    else:
        s_f = gla_final_state(cbk, cbv, cgf)
        s_b = gla_final_state(flip(cbk), flip(cbv), flip(cgb))
    o_f, _ = gla_chunked(bq, bk, bv, gf, s_f)
    o_b, _ = gla_chunked(flip(bq), flip(bk), flip(bv), flip(gb), s_b)
    y = ab_output(o_a, o_f + flip(o_b), bgate, gla_norm, w_out)
    return y, yc


def fourier_mixer(h, w_out, b_out):
    bsz, n_tok, _ = h.shape
    hg = h.astype(jnp.float32).reshape(bsz, n_tok, C_GROUPS, C_GROUP_DIM)
    f = jnp.fft.fft2(hg, axes=(1, 3), norm="ortho").real.reshape(bsz, n_tok, D_MODEL)
    return f.astype(h.dtype) @ w_out + b_out


def sq_relu_mlp(h, w1, w2):
    return jnp.square(jax.nn.relu(h @ w1)) @ w2


def setup_inputs(seed: int = 0) -> dict:
    key = jax.random.key(seed)
    ks = jax.random.split(key, 22)

    def nrm(k, shape, scale):
        return jax.random.normal(k, shape, jnp.float32) * scale

    def gain(k, shape):
        return 1.0 + 0.02 * jax.random.normal(k, shape, jnp.float32)

    return {
        "x": nrm(ks[0], (BATCH, SEQ, D_MODEL), 1.0),
        "c": nrm(ks[1], (BATCH, D_MODEL), 1.0),
        "ctx": nrm(ks[2], (BATCH, CTX_LEN, D_MODEL), 1.0),
        "c_ctx": nrm(ks[3], (D_MODEL,), 1.0),
        "ada_w": nrm(ks[4], (DEPTH, D_MODEL, 6 * D_MODEL), D_MODEL ** -0.5),
        "ada_b": nrm(ks[5], (DEPTH, 6 * D_MODEL), 0.02),
        "norm_mix": gain(ks[6], (DEPTH, D_MODEL)),
        "norm_mlp": gain(ks[7], (DEPTH, D_MODEL)),
        "mlp_w1": nrm(ks[8], (DEPTH, D_MODEL, D_FF), D_MODEL ** -0.5),
        "mlp_w2": nrm(ks[9], (DEPTH, D_FF, D_MODEL), D_FF ** -0.5),
        "ab_w_in": nrm(ks[10], (N_EVEN, D_MODEL, IN_COLS), D_MODEL ** -0.5),
        "ab_q_norm": gain(ks[11], (N_EVEN, HEAD_DIM)),
        "ab_k_norm": gain(ks[12], (N_EVEN, HEAD_DIM)),
        "ab_sink": nrm(ks[13], (N_EVEN, A_Q_HEADS), 0.5),
        "ab_gk_f": nrm(ks[14], (N_EVEN, B_GATE_RANK, B_QK_W), B_GATE_RANK ** -0.5),
        "ab_gk_f_bias": nrm(ks[15], (N_EVEN, B_QK_W), 0.1),
        "ab_gk_b": nrm(ks[16], (N_EVEN, B_GATE_RANK, B_QK_W), B_GATE_RANK ** -0.5),
        "ab_gk_b_bias": nrm(ks[17], (N_EVEN, B_QK_W), 0.1),
        "ab_gla_norm": gain(ks[18], (N_EVEN, B_DV)),
        "ab_w_out": nrm(ks[19], (N_EVEN, MIX_OUT, D_MODEL), MIX_OUT ** -0.5),
        "c_w_out": nrm(ks[20], (N_ODD, D_MODEL, D_MODEL), D_MODEL ** -0.5),
        "c_b_out": nrm(ks[21], (N_ODD, D_MODEL), 0.02),
    }


def reference(x, c, ctx, c_ctx, ada_w, ada_b, norm_mix, norm_mlp, mlp_w1, mlp_w2,
              ab_w_in, ab_q_norm, ab_k_norm, ab_sink, ab_gk_f, ab_gk_f_bias, ab_gk_b, ab_gk_b_bias,
              ab_gla_norm, ab_w_out, c_w_out, c_b_out):
    n_lat = x.shape[1]
    rows = n_lat // GRID_W
    ang_r, ang_c = axial_rope_angles(rows)
    silu_c = jax.nn.silu(c)
    silu_cc = jax.nn.silu(c_ctx)
    for layer in range(DEPTH):
        ctx_live = any(k % 2 == 0 for k in range(layer + 1, DEPTH))
        sh1, sc1, g1, sh2, sc2, g2 = jnp.split((silu_c @ ada_w[layer] + ada_b[layer])[:, None, :], 6, axis=-1)
        csh1, csc1, cg1, csh2, csc2, cg2 = jnp.split(silu_cc @ ada_w[layer] + ada_b[layer], 6, axis=-1)
        h = modulate(rms_norm(x, norm_mix[layer]), sh1, sc1)
        if layer % 2 == 0:
            i = layer // 2
            hc = modulate(rms_norm(ctx, norm_mix[layer]), csh1, csc1)
            y, yc = ab_mixer(h, hc, ctx_live, ab_w_in[i], ab_q_norm[i], ab_k_norm[i], ab_sink[i],
                             ab_gk_f[i], ab_gk_f_bias[i], ab_gk_b[i], ab_gk_b_bias[i],
                             ab_gla_norm[i], ab_w_out[i], ang_r, ang_c)
            if ctx_live:
                ctx = ctx + cg1 * yc
        else:
            j = layer // 2
            y = fourier_mixer(h, c_w_out[j], c_b_out[j])
            if ctx_live:
                hc = modulate(rms_norm(ctx, norm_mix[layer]), csh1, csc1)
                ctx = ctx + cg1 * fourier_mixer(hc, c_w_out[j], c_b_out[j])
        x = x + g1 * y
        x = x + g2 * sq_relu_mlp(modulate(rms_norm(x, norm_mlp[layer]), sh2, sc2), mlp_w1[layer], mlp_w2[layer])
        if ctx_live:
            ctx = ctx + cg2 * sq_relu_mlp(modulate(rms_norm(ctx, norm_mlp[layer]), csh2, csc2),
                                          mlp_w1[layer], mlp_w2[layer])
    return x
```

```cpp
#include <hip/hip_runtime.h>
#include <hip/hip_cooperative_groups.h>
#include <cstdio>
#include <cstdint>
namespace cg = cooperative_groups;

#define LAS __attribute__((address_space(3)))
typedef unsigned short bf16_t;
typedef short bf16x8 __attribute__((ext_vector_type(8)));
typedef float f32x4 __attribute__((ext_vector_type(4)));
typedef float f32x2 __attribute__((ext_vector_type(2)));
typedef unsigned u32x4 __attribute__((ext_vector_type(4)));
typedef unsigned u32x2 __attribute__((ext_vector_type(2)));

constexpr int D = 2048, NBATCH = 8, SEQ = 2048, CTXL = 256, NTOK = NBATCH * SEQ, NCTX = NBATCH * CTXL, NROWS = NTOK + NCTX;
constexpr int INC = 4640, INCP = 4864, DFF = 8192, KVLEN = SEQ + CTXL;
constexpr int C_AQ = 0, C_AK = 1024, C_AV = 1280, C_BQ = 1536, C_BK = 2048, C_BV = 2560, C_BG = 3584, C_LRF = 4608, C_LRB = 4624;
constexpr int LDS_BYTES = 131072 + 64;
constexpr int NPH = 17;

constexpr size_t WS_WIN = 0;
constexpr size_t WS_WOUT = WS_WIN + (size_t)INCP * D * 2;
constexpr size_t WS_CW = WS_WOUT + (size_t)D * D * 2;
constexpr size_t WS_W1 = WS_CW + (size_t)D * D * 2;
constexpr size_t WS_W2 = WS_W1 + (size_t)2 * DFF * D * 2;
constexpr size_t WS_CN = WS_W2 + (size_t)2 * DFF * D * 2;
constexpr size_t WS_CMA = WS_CN + (size_t)2048 * 4096 * 2;
constexpr size_t WS_MOD = WS_CMA + (size_t)512 * 256 * 2;
constexpr size_t WS_X = WS_MOD + (size_t)2 * 9 * 12288 * 4;
constexpr size_t WS_H = WS_X + (size_t)NTOK * D * 4;
constexpr size_t WS_MIX = WS_H + (size_t)NROWS * D * 2;
constexpr size_t WS_BIG = WS_MIX + (size_t)NTOK * D * 2;
constexpr size_t WS_PROJ = WS_BIG;
constexpr size_t WS_QP = WS_PROJ + (size_t)NROWS * INCP * 2;
constexpr size_t WS_KP = WS_QP + (size_t)NBATCH * 8 * SEQ * 128 * 2;
constexpr size_t WS_VTA = WS_KP + (size_t)NBATCH * 2 * KVLEN * 128 * 2;
constexpr size_t WS_QE = WS_VTA + (size_t)NBATCH * 2 * 128 * KVLEN * 2;
constexpr size_t WS_VT = WS_QE + (size_t)64 * KVLEN * 128 * 2;
constexpr size_t WS_DEC = WS_VT + (size_t)NBATCH * 4 * 256 * KVLEN * 2;
constexpr size_t WS_END = WS_DEC + (size_t)64 * 36 * 128 * 4;
constexpr size_t WS_KE = WS_H;
constexpr size_t WS_KDT = WS_H + (size_t)64 * KVLEN * 128 * 2;
constexpr size_t WS_HID = WS_BIG;
constexpr size_t WS_GT = WS_BIG;
static_assert(WS_HID + (size_t)NTOK * DFF * 2 <= WS_END, "hid overlay");
static_assert(WS_KDT + (size_t)64 * 36 * 128 * 64 * 2 <= WS_MIX, "KE/KDT overlay");
constexpr size_t WS_BAR = WS_END;
constexpr size_t WS_TOTAL = WS_BAR + 16384;
static_assert(WS_BAR % 256 == 0 && WS_TOTAL <= (size_t)805306368, "workspace");

struct Params { const float* in[22]; float* out; unsigned char* ws; int ph_lo, ph_hi; };

__device__ __forceinline__ float bf2f(bf16_t h) { return __uint_as_float(((unsigned)h) << 16); }
typedef __bf16 bf16v2_t __attribute__((ext_vector_type(2)));
__device__ __forceinline__ unsigned cvt_pk_bf16(float lo, float hi) { const f32x2 v = {lo, hi}; const bf16v2_t b = __builtin_convertvector(v, bf16v2_t); return __builtin_bit_cast(unsigned, b); }
__device__ __forceinline__ bf16_t f2bf1(float x) { return (bf16_t)(cvt_pk_bf16(x, 0.f) & 0xffffu); }
__device__ __forceinline__ float wave_sum(float v) {
#pragma unroll
    for (int o = 1; o < 64; o <<= 1) v += __shfl_xor(v, o);
    return v;
}
__device__ __forceinline__ float silu_f(float x) { return x / (1.f + __expf(-x)); }

constexpr int BM = 256, BK = 64, HALF = 128, HTB = HALF * BK * 2, NXCD = 8, WGM = 8;
__device__ __forceinline__ int lds_byte(int r, int c) { const int st = (r >> 4) * 2 + (c >> 5), rr = r & 15, cc = c & 31, ob = rr * 64 + cc * 2; return st * 1024 + (ob ^ (((ob >> 9) & 1) << 5)); }
__device__ __forceinline__ void stage_rc(int b, int& R, int& C) { const int st = b / 1024, sb = b % 1024, swz = sb ^ (((sb >> 9) & 1) << 5); R = (st >> 1) * 16 + swz / 64; C = (st & 1) * 32 + (swz % 64) / 2; }
__device__ __forceinline__ int perm32(int rho) { const int n = rho >> 4, i = rho & 15; return 8 * (i >> 2) + 4 * n + (i & 3); }

struct Unit { int pm, pn, pb; };
struct GemmP {
    const char* A; const char* B;
    int lda, ldb, K;
    int nM, nN, nB;
    int extra;
    size_t b_bs_hi, b_bs_lo;
    int mode;
    int act;
    float scale;
    void* out; int ldc;
    size_t o_bs_hi, o_bs_lo, o_pm;
    const float* base; const float* gate; const float* bias;
    int base16, out16;
};

__device__ __forceinline__ bool gemm_next(const GemmP& g, int i, Unit& u) {
    if (g.act == 2) {
        const int L2 = i * (int)gridDim.x + (int)blockIdx.x; if (L2 >= g.nB * 9) return false;
        u.pb = L2 / 9; const int r = L2 - u.pb * 9; u.pm = r < 5 ? 0 : 1; u.pn = r < 5 ? r : r - 1; return true; }
    const int nwg = g.nM * g.nN; const int L = i * (int)gridDim.x + (int)blockIdx.x; if (L >= nwg * g.nB + g.extra) return false;
    if (L >= nwg * g.nB) { const int q = L - nwg * g.nB, r = q & 7; u.pb = 0; u.pm = g.nM + (q >> 3); u.pn = r < 2 ? 4 + r : 6 + r; return true; }
    u.pb = L / nwg; int wgid = L - u.pb * nwg;
    { const int q = nwg / NXCD, r = nwg % NXCD, xcd = wgid % NXCD, off = wgid / NXCD; wgid = (xcd < r ? xcd * (q + 1) : r * (q + 1) + (xcd - r) * q) + off; }
    const int nig = WGM * g.nN, gid = wgid / nig, fm = gid * WGM, gsz = (g.nM - fm) < WGM ? (g.nM - fm) : WGM;
    u.pm = fm + ((wgid % nig) % gsz); u.pn = (wgid % nig) / gsz; return true;
}

__device__ __forceinline__ void gemm_epi(const GemmP& g, const f32x4 (&acc)[2][2][4][2], const Unit& u, int wr, int wc, int fr, int fq) {
    const size_t obase = (size_t)(u.pb >> 3) * g.o_bs_hi + (size_t)(u.pb & 7) * g.o_bs_lo + (size_t)u.pm * g.o_pm + (size_t)u.pn * 256;
    const int rl0 = wr * 64 + fr;
    if (g.mode == 0) {
        bf16_t* O = (bf16_t*)g.out + obase + wc * 32 + 8 * fq;
        const float sc = g.scale; const bool act = g.act == 1;
        const bool cd = g.act == 2; const bool cd_first = cd && u.pn == 4 && wc == 0 && fq == 0;
        if (cd && ((u.pm == 0 && u.pn > 4) || (u.pm == 1 && u.pn < 4))) return;
#pragma unroll
        for (int ai = 0; ai < 2; ++ai)
#pragma unroll
            for (int m = 0; m < 4; ++m) { bf16_t* rowp = O + (size_t)(rl0 + ai * HALF + m * 16) * g.ldc;
#pragma unroll
                for (int bj = 0; bj < 2; ++bj) { f32x4 v0 = acc[ai][bj][m][0], v1 = acc[ai][bj][m][1];
                    if (act) {
#pragma unroll
                        for (int j = 0; j < 4; ++j) { const float a = fmaxf(v0[j], 0.f), b = fmaxf(v1[j], 0.f); v0[j] = a * a; v1[j] = b * b; } }
                    v0 = v0 * sc; v1 = v1 * sc;
                    u32x4 w; w.x = cvt_pk_bf16(v0[0], v0[1]); w.y = cvt_pk_bf16(v0[2], v0[3]); w.z = cvt_pk_bf16(v1[0], v1[1]); w.w = cvt_pk_bf16(v1[2], v1[3]);
                    if (!cd) *(u32x4*)(rowp + bj * HALF) = w;
                    else if (u.pm == 0) { if (u.pn < 4) *(u32x4*)(rowp + bj * HALF) = w; else if (cd_first && bj == 0) rowp[0] = (bf16_t)(w.x & 0xffffu); }
                    else { if (cd_first && bj == 0) { rowp[1] = (bf16_t)(w.x >> 16); *(unsigned*)(rowp + 2) = w.y; *(u32x2*)(rowp + 4) = (u32x2){w.z, w.w}; } else *(u32x4*)(rowp + bj * HALF) = w; } } }
    } else {
        const int cl0 = wc * 32 + 4 * fq, colg = u.pn * 256 + cl0;
        const float* gate = g.gate + (size_t)(u.pm >> 3) * 12288 + colg;
        f32x4 gv[2][2], bv[2][2];
#pragma unroll
        for (int bj = 0; bj < 2; ++bj)
#pragma unroll
            for (int n = 0; n < 2; ++n) { gv[bj][n] = *(const f32x4*)(gate + bj * HALF + n * 16);
                bv[bj][n] = g.bias ? *(const f32x4*)(g.bias + colg + bj * HALF + n * 16) : (f32x4){0.f, 0.f, 0.f, 0.f}; }
        float* outp = (float*)g.out;
#pragma unroll
        for (int ai = 0; ai < 2; ++ai) {
            u32x2 braw[4][2][2];
            if (g.base16) {
#pragma unroll
                for (int m = 0; m < 4; ++m) { const size_t off = obase + (size_t)(rl0 + ai * HALF + m * 16) * g.ldc + cl0;
#pragma unroll
                    for (int bj = 0; bj < 2; ++bj)
#pragma unroll
                        for (int n = 0; n < 2; ++n) braw[m][bj][n] = *(const u32x2*)((const bf16_t*)g.base + off + bj * HALF + n * 16); } }
#pragma unroll
            for (int m = 0; m < 4; ++m) { const size_t off = obase + (size_t)(rl0 + ai * HALF + m * 16) * g.ldc + cl0;
#pragma unroll
                for (int bj = 0; bj < 2; ++bj)
#pragma unroll
                    for (int n = 0; n < 2; ++n) { const size_t o2 = off + bj * HALF + n * 16; f32x4 bs;
                        if (g.base16) { const u32x2 w = braw[m][bj][n]; bs = (f32x4){__uint_as_float(w.x << 16), __uint_as_float(w.x & 0xffff0000u), __uint_as_float(w.y << 16), __uint_as_float(w.y & 0xffff0000u)}; }
                        else bs = *(const f32x4*)(g.base + o2);
                        const f32x4 r = bs + gv[bj][n] * (acc[ai][bj][m][n] + bv[bj][n]);
                        if (g.out16) { u32x2 w; w.x = cvt_pk_bf16(r[0], r[1]); w.y = cvt_pk_bf16(r[2], r[3]); *(u32x2*)((bf16_t*)g.out + o2) = w; }
                        else *(f32x4*)(outp + o2) = r; } }
            asm volatile("" ::: "memory"); }
    }
}

__device__ __forceinline__ void gemm_phase(LAS unsigned char* lds, const GemmP& g) {
    const int tid = threadIdx.x, wid = __builtin_amdgcn_readfirstlane(tid >> 6), lane = tid & 63, wr = wid >> 2, wc = wid & 3, fr = lane & 15, fq = lane >> 4;
    const int K = g.K, nt = K / BK; const bool perm = (g.mode == 0);
    unsigned voffA[2], voffB[2];
#pragma unroll
    for (int i = 0; i < 2; ++i) { int R, C; stage_rc(tid * 16 + i * 8192, R, C); const int Rb = perm ? ((R & ~31) + perm32(R & 31)) : R;
        voffA[i] = (unsigned)(R * g.lda + C) * 2u; voffB[i] = (unsigned)(Rb * g.ldb + C) * 2u; }
    const size_t kstep = (size_t)(BK * 2);
    const size_t hstepA = (size_t)HALF * g.lda * 2, hstepB = (size_t)HALF * g.ldb * 2;
    const size_t tstepA = 2 * hstepA, tstepB = 2 * hstepB;
    const unsigned ldsw = (unsigned)wid * 1024u;
    const int aoff = lds_byte(wr * 64 + fr, fq * 8), boff = lds_byte(wc * 32 + fr, fq * 8);
#define PG8_SA(b, h) (((b) * 2 + (h)) * HTB)
#define PG8_SB(b, h) ((4 + (b) * 2 + (h)) * HTB)
#define PG8_STAGE(bufoff, gbase, voff) do { const unsigned long long _u = (unsigned long long)(gbase); \
        const char* _gb = (const char*)(((unsigned long long)(unsigned)__builtin_amdgcn_readfirstlane((int)(unsigned)(_u >> 32)) << 32) | (unsigned long long)(unsigned)__builtin_amdgcn_readfirstlane((int)(unsigned)_u)); \
        _Pragma("unroll") for (int _i = 0; _i < 2; ++_i) \
        __builtin_amdgcn_global_load_lds((const unsigned*)(_gb + (voff)[_i]), (LAS unsigned*)(lds + (bufoff) + ldsw + _i * 8192), 16, 0, 0); } while (0)
#define PG8_LDA(dst, b, h) do { _Pragma("unroll") for (int m = 0; m < 4; ++m) _Pragma("unroll") for (int k = 0; k < 2; ++k) dst[m][k] = *(const LAS bf16x8*)(lds + PG8_SA(b, h) + aoff + m * 2048 + k * 1024); } while (0)
#define PG8_LDB(dst, b, h) do { _Pragma("unroll") for (int n = 0; n < 2; ++n) _Pragma("unroll") for (int k = 0; k < 2; ++k) dst[n][k] = *(const LAS bf16x8*)(lds + PG8_SB(b, h) + boff + n * 2048 + k * 1024); } while (0)
#define PG8_MMA(ai, bj, At, Bt) do { __builtin_amdgcn_s_setprio(1); _Pragma("unroll") for (int m = 0; m < 4; ++m) _Pragma("unroll") for (int n = 0; n < 2; ++n) _Pragma("unroll") for (int k = 0; k < 2; ++k) \
        acc[ai][bj][m][n] = __builtin_amdgcn_mfma_f32_16x16x32_bf16(Bt[n][k], At[m][k], acc[ai][bj][m][n], 0, 0, 0); __builtin_amdgcn_s_setprio(0); } while (0)
#define PG8_WAIT_V(n) asm volatile("s_waitcnt vmcnt(" #n ")" ::: "memory")
#define PG8_WAIT_L(n) asm volatile("s_waitcnt lgkmcnt(" #n ")" ::: "memory")
#define PG8_BAR __builtin_amdgcn_s_barrier()
#define PG8_SCHED __builtin_amdgcn_sched_barrier(0)
#define PG8_APTR(u) (g.A + (size_t)(u).pm * tstepA)
#define PG8_BPTR(u) (g.B + (size_t)((u).pb >> 3) * g.b_bs_hi + (size_t)((u).pb & 7) * g.b_bs_lo + (size_t)(u).pn * tstepB)
    Unit cur, nxt; int ui = 0;
    if (!gemm_next(g, 0, cur)) return;
    f32x4 acc[2][2][4][2];
#pragma unroll
    for (int a = 0; a < 2; ++a)
#pragma unroll
        for (int b = 0; b < 2; ++b)
#pragma unroll
            for (int m = 0; m < 4; ++m)
#pragma unroll
                for (int n = 0; n < 2; ++n) acc[a][b][m][n] = (f32x4){0.f, 0.f, 0.f, 0.f};
    bf16x8 At[4][2], B0[2][2], B1[2][2];
    const char* cA = PG8_APTR(cur); const char* cB = PG8_BPTR(cur);
    PG8_STAGE(PG8_SB(0, 0), cB, voffB); PG8_STAGE(PG8_SB(0, 1), cB + hstepB, voffB); PG8_STAGE(PG8_SA(0, 0), cA, voffA); PG8_STAGE(PG8_SA(0, 1), cA + hstepA, voffA);
    if (wr == 1) PG8_BAR;
    PG8_WAIT_V(2); PG8_BAR;
    PG8_STAGE(PG8_SB(1, 0), cB + kstep, voffB); PG8_STAGE(PG8_SA(1, 0), cA + kstep, voffA); PG8_STAGE(PG8_SB(1, 1), cB + hstepB + kstep, voffB);
    PG8_WAIT_V(6); PG8_BAR;
    for (;;) {
        const bool has_next = gemm_next(g, ui + 1, nxt);
        const char* nA = has_next ? PG8_APTR(nxt) : cA; const char* nB = has_next ? PG8_BPTR(nxt) : cB;
        for (int t = 0; t < nt; t += 2) {
            const bool last = (t == nt - 2);
            const char* a1 = cA + (size_t)(t + 1) * kstep;
            const char* a2 = last ? nA : cA + (size_t)(t + 2) * kstep; const char* b2 = last ? nB : cB + (size_t)(t + 2) * kstep;
            const char* a3 = a2 + kstep; const char* b3 = b2 + kstep;
            PG8_LDB(B0, 0, 0); PG8_LDB(B1, 0, 1); PG8_SCHED; PG8_LDA(At, 0, 0); PG8_STAGE(PG8_SA(1, 1), a1 + hstepA, voffA);
            PG8_WAIT_V(8); PG8_WAIT_L(0); PG8_BAR; PG8_MMA(0, 0, At, B0); PG8_MMA(0, 1, At, B1); PG8_BAR; PG8_SCHED;
            PG8_LDA(At, 0, 1); PG8_STAGE(PG8_SB(0, 0), b2, voffB); PG8_STAGE(PG8_SB(0, 1), b2 + hstepB, voffB); PG8_STAGE(PG8_SA(0, 0), a2, voffA);
            PG8_WAIT_V(8); PG8_WAIT_L(0); PG8_BAR; PG8_MMA(1, 0, At, B0); PG8_MMA(1, 1, At, B1); PG8_BAR; PG8_SCHED;
            PG8_LDB(B0, 1, 0); PG8_LDB(B1, 1, 1); PG8_SCHED; PG8_LDA(At, 1, 0); PG8_STAGE(PG8_SA(0, 1), a2 + hstepA, voffA);
            PG8_WAIT_V(8); PG8_WAIT_L(0); PG8_BAR; PG8_MMA(0, 0, At, B0); PG8_MMA(0, 1, At, B1); PG8_BAR; PG8_SCHED;
            PG8_LDA(At, 1, 1); PG8_STAGE(PG8_SB(1, 0), b3, voffB); PG8_STAGE(PG8_SB(1, 1), b3 + hstepB, voffB); PG8_STAGE(PG8_SA(1, 0), a3, voffA);
            PG8_WAIT_V(8); PG8_WAIT_L(0); PG8_BAR; PG8_MMA(1, 0, At, B0); PG8_MMA(1, 1, At, B1); PG8_BAR; PG8_SCHED;
        }
        if (wr == 0) PG8_BAR;
        gemm_epi(g, acc, cur, wr, wc, fr, fq);
        if (!has_next) break;
#pragma unroll
        for (int a = 0; a < 2; ++a)
#pragma unroll
            for (int b = 0; b < 2; ++b)
#pragma unroll
                for (int m = 0; m < 4; ++m)
#pragma unroll
                    for (int n = 0; n < 2; ++n) acc[a][b][m][n] = (f32x4){0.f, 0.f, 0.f, 0.f};
        cur = nxt; cA = nA; cB = nB; ++ui;
        if (wr == 1) PG8_BAR;
    }
    PG8_WAIT_V(0);
    PG8_BAR;
#undef PG8_SA
#undef PG8_SB
#undef PG8_STAGE
#undef PG8_LDA
#undef PG8_LDB
#undef PG8_MMA
#undef PG8_WAIT_V
#undef PG8_WAIT_L
#undef PG8_BAR
#undef PG8_SCHED
#undef PG8_APTR
#undef PG8_BPTR
}

__device__ __forceinline__ GemmP gemm_std(const void* A, int lda, const void* B, int ldb, int K, int nM, int nN) {
    GemmP g; g.A = (const char*)A; g.B = (const char*)B; g.lda = lda; g.ldb = ldb; g.K = K; g.nM = nM; g.nN = nN; g.nB = 1; g.extra = 0; g.b_bs_hi = 0; g.b_bs_lo = 0;
    g.mode = 0; g.act = 0; g.scale = 1.f; g.out = nullptr; g.ldc = 0; g.o_bs_hi = 0; g.o_bs_lo = 0; g.o_pm = 0; g.base = nullptr; g.gate = nullptr; g.bias = nullptr; g.base16 = 0; g.out16 = 0; return g;
}


#define XB_TMO      128
#define XB_XCNT(j)  (256  + 64 * (j))
#define XB_XSUB(j)  (1280 + 64 * (j))
#define XB_XGEN(j)  (2304 + 64 * (j))
#define XB_TOP      3328
#define XB_TOPGEN   3392
#define XCD_BAR_WORDS 3456
#define XB_SPIN_CAP (1u << 18)
__device__ __forceinline__ unsigned xb_ld(unsigned* p)              { return __hip_atomic_load(p, __ATOMIC_RELAXED, __HIP_MEMORY_SCOPE_AGENT); }
__device__ __forceinline__ unsigned xb_add(unsigned* p, unsigned v) { return __hip_atomic_fetch_add(p, v, __ATOMIC_RELAXED, __HIP_MEMORY_SCOPE_AGENT); }
__device__ __forceinline__ unsigned xb_xcc_id() { return (unsigned)__builtin_amdgcn_s_getreg((3 << 11) | 20) & 0xFu; }
#define XB_SPIN(cond, bar) do { unsigned _sp = 0; while (cond) { __builtin_amdgcn_s_sleep(1); \
    if ((++_sp & 255u) == 0u) { if (xb_ld(&(bar)[XB_TMO])) break; if (_sp > XB_SPIN_CAP) { atomicAdd(&(bar)[XB_TMO], 1u); break; } } } } while (0)
struct XcdBarrier { unsigned* bar; unsigned x; volatile LAS unsigned* st; };
__device__ __forceinline__ XcdBarrier xcd_barrier_post(unsigned* bar, volatile LAS unsigned* st) {
    XcdBarrier b; b.bar = bar; b.x = xb_xcc_id(); b.st = st;
    if (threadIdx.x == 0) (void)xb_add(&bar[XB_XCNT(b.x)], 1u);
    return b;
}
__device__ __forceinline__ void xcd_barrier_complete(unsigned* bar, unsigned x, unsigned& nloc, unsigned& nx) {
    const unsigned G = gridDim.x * gridDim.y * gridDim.z;
    unsigned sum, cnt, mine, sp = 0u;
    for (;;) {
        sum = 0u; cnt = 0u; mine = 0u;
#pragma unroll
        for (unsigned j = 0; j < 16; ++j) { const unsigned c = xb_ld(&bar[XB_XCNT(j)]); sum += c; cnt += (c > 0u) ? 1u : 0u; mine = (j == x) ? c : mine; }
        if (sum == G) break;
        __builtin_amdgcn_s_sleep(1);
        if ((++sp & 255u) == 0u) { if (xb_ld(&bar[XB_TMO])) break; if (sp > XB_SPIN_CAP) { atomicAdd(&bar[XB_TMO], 1u); break; } }
    }
    nloc = mine > 0u ? mine : 1u; nx = cnt > 0u ? cnt : 1u;
}
__device__ __forceinline__ void xcd_barrier(const XcdBarrier& b) {
    asm volatile("s_waitcnt vmcnt(0) lgkmcnt(0)" ::: "memory");
    __syncthreads();
    if (threadIdx.x == 0) {
        unsigned* bar = b.bar;
        __builtin_amdgcn_s_waitcnt(0);
        unsigned nloc = b.st[0], nx = b.st[1];
        if (nloc == 0u) { xcd_barrier_complete(bar, b.x, nloc, nx); b.st[0] = nloc; b.st[1] = nx; }
        const unsigned old = xb_add(&bar[XB_XSUB(b.x)], 1u);
        const unsigned gen = old / nloc;
        if (old + 1u == (gen + 1u) * nloc) {
            __builtin_amdgcn_fence(__ATOMIC_RELEASE, "agent");
            asm volatile("s_waitcnt vmcnt(0)" ::: "memory");
            const unsigned og = xb_add(&bar[XB_TOP], 1u);
            const unsigned tg = og / nx;
            if (og + 1u == (tg + 1u) * nx) xb_add(&bar[XB_TOPGEN], 1u);
            else XB_SPIN(xb_ld(&bar[XB_TOPGEN]) == tg, bar);
            __builtin_amdgcn_fence(__ATOMIC_ACQUIRE, "agent");
            xb_add(&bar[XB_XGEN(b.x)], 1u);
            asm volatile("s_waitcnt vmcnt(0)" ::: "memory");
        } else {
            XB_SPIN(xb_ld(&bar[XB_XGEN(b.x)]) == gen, bar);
            __builtin_amdgcn_fence(__ATOMIC_ACQUIRE, "agent");
            asm volatile("s_waitcnt vmcnt(0)" ::: "memory");
        }
    }
    __syncthreads();
}

__device__ __forceinline__ void ada_phase(const Params& P, LAS unsigned char* lds) {
    const int tid = threadIdx.x;
    LAS f32x4* sA = (LAS f32x4*)lds;
    LAS f32x4* sB = sA + 2048;
    LAS float* sC = (LAS float*)(sB + 2048);
    LAS float* part = sC + 2048;
    const float* c = P.in[1]; const float* cc = P.in[3];
    for (int i = tid; i < 2048; i += 512) {
        sA[i] = (f32x4){silu_f(c[0 * 2048 + i]), silu_f(c[1 * 2048 + i]), silu_f(c[2 * 2048 + i]), silu_f(c[3 * 2048 + i])};
        sB[i] = (f32x4){silu_f(c[4 * 2048 + i]), silu_f(c[5 * 2048 + i]), silu_f(c[6 * 2048 + i]), silu_f(c[7 * 2048 + i])};
        sC[i] = silu_f(cc[i]); }
    __syncthreads();
    float* mod = (float*)(P.ws + WS_MOD);
    for (int cb = blockIdx.x; cb < 256; cb += gridDim.x) {
        const int colbase = cb * 96, l = colbase / 12288, cl = colbase % 12288;
        const float* W = P.in[4] + (size_t)l * 2048 * 12288 + cl;
        const int c4 = tid % 24, kp = tid / 24;
        if (tid < 384) {
            f32x4 acc[9];
#pragma unroll
            for (int r = 0; r < 9; ++r) acc[r] = (f32x4){0.f, 0.f, 0.f, 0.f};
            const float* wp = W + (size_t)(kp * 128) * 12288 + c4 * 4;
            for (int i0 = 0; i0 < 128; i0 += 16) {
                f32x4 wv[16];
#pragma unroll
                for (int u = 0; u < 16; ++u) wv[u] = __builtin_nontemporal_load((const f32x4*)(wp + (size_t)(i0 + u) * 12288));
#pragma unroll
                for (int u = 0; u < 16; ++u) { const int i = i0 + u; const f32x4 w = wv[u];
                    const f32x4 s0 = sA[kp * 128 + i], s1 = sB[kp * 128 + i]; const float s2 = sC[kp * 128 + i];
                    acc[0] += w * s0[0]; acc[1] += w * s0[1]; acc[2] += w * s0[2]; acc[3] += w * s0[3];
                    acc[4] += w * s1[0]; acc[5] += w * s1[1]; acc[6] += w * s1[2]; acc[7] += w * s1[3];
                    acc[8] += w * s2; }
            }
#pragma unroll
            for (int r = 0; r < 9; ++r) *(LAS f32x4*)(part + kp * 864 + r * 96 + c4 * 4) = acc[r];
        }
        __syncthreads();
        for (int o = tid; o < 864; o += 512) {
            float s = 0.f;
#pragma unroll
            for (int k = 0; k < 16; ++k) s += part[k * 864 + o];
            const int r = o / 96, col = o % 96;
            mod[(size_t)(l * 9 + r) * 12288 + cl + col] = s + P.in[5][l * 12288 + cl + col];
        }
        __syncthreads();
    }
}

__device__ __forceinline__ void transpose_item(const float* W, int K, int N, bf16_t* WT, LAS float* scr, int item, int lane) {
    const int nblk = N / 32, kb = item / nblk, nb = item % nblk, k0 = 64 * kb, n0 = 32 * nb;
    float v[32];
    const float* wp = W + (size_t)(k0 + (lane >> 5)) * N + n0 + (lane & 31);
#pragma unroll
    for (int i = 0; i < 32; ++i) v[i] = __builtin_nontemporal_load(wp + (size_t)(2 * i) * N);
#pragma unroll
    for (int i = 0; i < 32; ++i) scr[(2 * i + (lane >> 5)) * 33 + (lane & 31)] = v[i];
    asm volatile("s_waitcnt lgkmcnt(0)" ::: "memory");
    const int c = lane & 7;
#pragma unroll
    for (int j = 0; j < 4; ++j) { const int n = (lane >> 3) + 8 * j; const LAS float* s = scr + (8 * c) * 33 + n;
        u32x4 o; o.x = cvt_pk_bf16(s[0 * 33], s[1 * 33]); o.y = cvt_pk_bf16(s[2 * 33], s[3 * 33]); o.z = cvt_pk_bf16(s[4 * 33], s[5 * 33]); o.w = cvt_pk_bf16(s[6 * 33], s[7 * 33]);
        *(u32x4*)(WT + (size_t)(n0 + n) * K + k0 + 8 * c) = o; }
    asm volatile("s_waitcnt lgkmcnt(0)" ::: "memory");
}

__device__ __forceinline__ void weights_phase(const Params& P, LAS unsigned char* lds) {
    const int tid = threadIdx.x, lane = tid & 63, wave = __builtin_amdgcn_readfirstlane(tid >> 6);
    LAS float* scr = (LAS float*)(lds + wave * 8704);
    const int gw = blockIdx.x * 8 + wave, NGW = gridDim.x * 8;
    constexpr int I_IN = (D / 64) * (INC / 32), I_SQ = (D / 64) * (D / 32), I_1 = (D / 64) * (DFF / 32), I_2 = (DFF / 64) * (D / 32);
    constexpr int NIT = I_IN + 2 * I_SQ + 2 * I_1 + 2 * I_2;
    bf16_t* ws16;
    for (int it = gw; it < NIT; it += NGW) {
        int r = it;
        if (r < I_IN) { ws16 = (bf16_t*)(P.ws + WS_WIN); transpose_item(P.in[10], D, INC, ws16, scr, r, lane); continue; } r -= I_IN;
        if (r < I_SQ) { ws16 = (bf16_t*)(P.ws + WS_WOUT); transpose_item(P.in[19], D, D, ws16, scr, r, lane); continue; } r -= I_SQ;
        if (r < I_SQ) { ws16 = (bf16_t*)(P.ws + WS_CW); transpose_item(P.in[20], D, D, ws16, scr, r, lane); continue; } r -= I_SQ;
        if (r < 2 * I_1) { const int l = r / I_1; ws16 = (bf16_t*)(P.ws + WS_W1) + (size_t)l * DFF * D; transpose_item(P.in[8] + (size_t)l * D * DFF, D, DFF, ws16, scr, r % I_1, lane); continue; } r -= 2 * I_1;
        { const int l = r / I_2; ws16 = (bf16_t*)(P.ws + WS_W2) + (size_t)l * D * DFF; transpose_item(P.in[9] + (size_t)l * DFF * D, DFF, D, ws16, scr, r % I_2, lane); }
    }
    const int gt = blockIdx.x * 512 + tid, NGT = gridDim.x * 512;
    bf16_t* CN = (bf16_t*)(P.ws + WS_CN);
    for (int idx = gt; idx < 2048 * 256; idx += NGT) { const int k = idx >> 8, j0 = (idx & 255) * 8; float v[8];
#pragma unroll
        for (int e = 0; e < 8; ++e) { const int j = j0 + e; const int t = j & 1023; const float a = (float)((k * t) & 2047) * (1.f / 1024.f);
            v[e] = (j < 1024) ? cospif(a) : (t == 0 ? ((k & 1) ? -1.f : 1.f) : -sinpif(a)); }
        u32x4 o; o.x = cvt_pk_bf16(v[0], v[1]); o.y = cvt_pk_bf16(v[2], v[3]); o.z = cvt_pk_bf16(v[4], v[5]); o.w = cvt_pk_bf16(v[6], v[7]);
        *(u32x4*)(CN + (size_t)k * 2048 + j0) = o; }
    bf16_t* CMA = (bf16_t*)(P.ws + WS_CMA);
    for (int idx = gt; idx < 512 * 32; idx += NGT) { const int r = idx >> 5, c0 = (idx & 31) * 8; float v[8];
#pragma unroll
        for (int e = 0; e < 8; ++e) { const int cix = c0 + e; const float a = (float)(((r & 255) * cix) & 255) * (1.f / 128.f); v[e] = (r < 256) ? cospif(a) : sinpif(a); }
        u32x4 o; o.x = cvt_pk_bf16(v[0], v[1]); o.y = cvt_pk_bf16(v[2], v[3]); o.z = cvt_pk_bf16(v[4], v[5]); o.w = cvt_pk_bf16(v[6], v[7]);
        *(u32x4*)(CMA + (size_t)r * 256 + c0) = o; }
}

__device__ __forceinline__ f32x4 ld4_bf16(const bf16_t* p) { const u32x2 w = *(const u32x2*)p; return (f32x4){__uint_as_float(w.x << 16), __uint_as_float(w.x & 0xffff0000u), __uint_as_float(w.y << 16), __uint_as_float(w.y & 0xffff0000u)}; }
__device__ __forceinline__ void norm_phase(const float* src_lat, const float* src_ctx, int nrows, const float* gain, const float* mod_l, int sh_chunk, int sc_chunk, bf16_t* dst, const bf16_t* lr_t = nullptr, bf16_t* lr_out = nullptr, const bf16_t* src16 = nullptr, LAS unsigned char* lds = nullptr) {
    const int tid = threadIdx.x, lane = tid & 63, wave = tid >> 6;
    if (lr_t != nullptr) {
        const u32x4* s4 = (const u32x4*)(lr_t + (size_t)C_LRF * D);
        for (int i = tid; i < 32 * D * 2 / 16; i += 512) ((LAS u32x4*)lds)[i] = s4[i];
        __syncthreads();
    }
    const int gw = blockIdx.x * 8 + wave, nw = gridDim.x * 8, per = (NTOK + nw - 1) / nw; const bool contig = (per * nw == NTOK);
    const int nctx_it = nrows > NTOK ? (nrows - NTOK + nw - 1) / nw : 0;
    f32x4 gam[8], shv[8]; int curb = -1;
    for (int it = 0; it < per + nctx_it; ++it) {
        const int row = it < per ? (contig ? gw * per + it : gw + it * nw) : NTOK + gw + (it - per) * nw;
        if (row >= nrows || (it < per && row >= NTOK)) continue;
        const float* xr = row < NTOK ? src_lat + (size_t)row * D : src_ctx + (size_t)(row - NTOK) * D;
        const int mr = row < NTOK ? (row >> 11) : 8;
        if (mr != curb) { curb = mr; const float* sh = mod_l + (size_t)mr * 12288 + sh_chunk * 2048; const float* sc = mod_l + (size_t)mr * 12288 + sc_chunk * 2048;
#pragma unroll
            for (int j = 0; j < 8; ++j) { const int c0 = (lane + 64 * j) * 4; gam[j] = *(const f32x4*)(gain + c0) * (*(const f32x4*)(sc + c0) + 1.f); shv[j] = *(const f32x4*)(sh + c0); } }
        f32x4 v[8]; float ss = 0.f;
#pragma unroll
        for (int j = 0; j < 8; ++j) { v[j] = src16 ? ld4_bf16(src16 + (size_t)row * D + (lane + 64 * j) * 4) : *(const f32x4*)(xr + (lane + 64 * j) * 4); ss += (v[j][0] * v[j][0] + v[j][1] * v[j][1]) + (v[j][2] * v[j][2] + v[j][3] * v[j][3]); }
        const float rstd = rsqrtf(wave_sum(ss) * (1.f / D) + 1e-6f);
#pragma unroll
        for (int j = 0; j < 8; ++j) { const int c0 = (lane + 64 * j) * 4;
            const f32x4 y = v[j] * rstd * gam[j] + shv[j];
            u32x2 w; w.x = cvt_pk_bf16(y[0], y[1]); w.y = cvt_pk_bf16(y[2], y[3]);
            *(u32x2*)(dst + (size_t)row * D + c0) = w; v[j] = y; }
        if (lr_t != nullptr && row >= NTOK) {
            float mine = 0.f;
#pragma unroll 4
            for (int c = 0; c < 32; ++c) { const LAS unsigned char* wr = lds + c * 4096 + lane * 8; float a = 0.f;
#pragma unroll
                for (int j = 0; j < 8; ++j) { const u32x2 w = *(const LAS u32x2*)(wr + j * 512);
                    a += (v[j][0] * __uint_as_float(w.x << 16) + v[j][1] * __uint_as_float(w.x & 0xffff0000u)) + (v[j][2] * __uint_as_float(w.y << 16) + v[j][3] * __uint_as_float(w.y & 0xffff0000u)); }
                const float s = wave_sum(a); mine = (lane == c) ? s : mine; }
            if (lane < 32) lr_out[(size_t)row * INCP + C_LRF + lane] = f2bf1(mine);
        }
    }
}


__device__ __forceinline__ void norm_pair_phase(const bf16_t* src, const float* gain, const float* mod_l, bf16_t* dst) {
    const int tid = threadIdx.x, lane = tid & 63, wave = tid >> 6;
    const int gw = blockIdx.x * 8 + wave, nw = gridDim.x * 8;
    const int wpb = nw / NBATCH; const bool ok = (wpb * NBATCH == nw) && wpb > 0;
    const int per = ok ? (1025 + wpb - 1) / wpb : 0;
    const int b0 = ok ? gw / wpb : 0, wb = ok ? gw - b0 * wpb : 0;
    f32x4 gam[8], shv[8]; int curb = -1;
    const int total = ok ? per : (NBATCH * 1025 + nw - 1) / nw;
    for (int it = 0; it < total; ++it) {
        int b, j;
        if (ok) { b = b0; j = wb * per + it; if (j > 1024) continue; }
        else { const int idx = gw + it * nw; if (idx >= NBATCH * 1025) continue; b = idx / 1025; j = idx - b * 1025; }
        if (b != curb) { curb = b; const float* sh = mod_l + (size_t)b * 12288 + 0 * 2048; const float* sc = mod_l + (size_t)b * 12288 + 1 * 2048;
#pragma unroll
            for (int q = 0; q < 8; ++q) { const int c0 = (lane + 64 * q) * 4; gam[q] = *(const f32x4*)(gain + c0) * (*(const f32x4*)(sc + c0) + 1.f); shv[q] = *(const f32x4*)(sh + c0); } }
        const bool pair = (j >= 1 && j <= 1023);
        const bf16_t* x1 = src + (size_t)(b * SEQ + j) * D; const bf16_t* x2 = src + (size_t)(b * SEQ + (pair ? SEQ - j : j)) * D;
        f32x4 v1[8], v2[8]; float s1 = 0.f, s2 = 0.f;
#pragma unroll
        for (int q = 0; q < 8; ++q) { v1[q] = ld4_bf16(x1 + (lane + 64 * q) * 4); v2[q] = ld4_bf16(x2 + (lane + 64 * q) * 4);
            s1 += (v1[q][0] * v1[q][0] + v1[q][1] * v1[q][1]) + (v1[q][2] * v1[q][2] + v1[q][3] * v1[q][3]);
            s2 += (v2[q][0] * v2[q][0] + v2[q][1] * v2[q][1]) + (v2[q][2] * v2[q][2] + v2[q][3] * v2[q][3]); }
        const float r1 = rsqrtf(wave_sum(s1) * (1.f / D) + 1e-6f), r2 = rsqrtf(wave_sum(s2) * (1.f / D) + 1e-6f);
        bf16_t* de = dst + (size_t)(b * SEQ + (j == 1024 ? 1024 : j)) * D; bf16_t* dq = dst + (size_t)(b * SEQ + 1024 + j) * D;
#pragma unroll
        for (int q = 0; q < 8; ++q) { const int c0 = (lane + 64 * q) * 4;
            const f32x4 y1 = v1[q] * r1 * gam[q] + shv[q], y2 = v2[q] * r2 * gam[q] + shv[q];
            const f32x4 e4 = pair ? y1 + y2 : y1, o4 = y1 - y2;
            u32x2 w; w.x = cvt_pk_bf16(e4[0], e4[1]); w.y = cvt_pk_bf16(e4[2], e4[3]);
            *(u32x2*)(de + c0) = w;
            if (pair) { u32x2 w2; w2.x = cvt_pk_bf16(o4[0], o4[1]); w2.y = cvt_pk_bf16(o4[2], o4[3]); *(u32x2*)(dq + c0) = w2; } }
    }
}

__device__ __forceinline__ float log_sigmoid_f(float z) { return fminf(z, 0.f) - __logf(1.f + __expf(-fabsf(z))); }

constexpr float QSCALE = 0.08838834764831845f, LOG2E = 1.4426950408889634f;

__device__ __forceinline__ void prep_phase(const Params& P, LAS unsigned char* lds) {
    const int tid = threadIdx.x;
    const bf16_t* proj = (const bf16_t*)(P.ws + WS_PROJ);
    bf16_t* Qp = (bf16_t*)(P.ws + WS_QP); bf16_t* Kp = (bf16_t*)(P.ws + WS_KP);
    {
        const int i = tid & 31; const float invf = powf(10000.f, -(float)i / 32.f);
        const int NHR = NTOK * 10 + NCTX * 2;
        const float gq0 = P.in[11][i], gq1 = P.in[11][32 + i], gq2 = P.in[11][64 + i], gq3 = P.in[11][96 + i];
        const float gk0 = P.in[12][i], gk1 = P.in[12][32 + i], gk2 = P.in[12][64 + i], gk3 = P.in[12][96 + i];
        const int hw = blockIdx.x * 16 + (tid >> 5), nhw = gridDim.x * 16;
        for (int base = 0; base < NHR; base += 4 * nhw) {
            float xv[4][4]; int rows[4], hhs[4];
#pragma unroll
            for (int u = 0; u < 4; ++u) {
                int idx = base + u * nhw + hw; if (idx >= NHR) idx = NHR - 1;
                int row, hh; if (idx < NTOK * 10) { row = idx / 10; hh = idx - row * 10; } else { const int j = idx - NTOK * 10; row = NTOK + (j >> 1); hh = 8 + (j & 1); }
                rows[u] = row; hhs[u] = hh;
                const int col0 = hh < 8 ? hh * 128 : C_AK + (hh - 8) * 128;
                const bf16_t* pr = proj + (size_t)row * INCP + col0 + i;
                xv[u][0] = bf2f(pr[0]); xv[u][1] = bf2f(pr[32]); xv[u][2] = bf2f(pr[64]); xv[u][3] = bf2f(pr[96]);
            }
#pragma unroll
            for (int u = 0; u < 4; ++u) {
                const int row = rows[u], hh = hhs[u];
                float x0 = xv[u][0], x1 = xv[u][1], x2 = xv[u][2], x3 = xv[u][3];
                float ss = x0 * x0 + x1 * x1 + x2 * x2 + x3 * x3;
#pragma unroll
                for (int o = 1; o < 32; o <<= 1) ss += __shfl_xor(ss, o);
                const float rstd = rsqrtf(ss * (1.f / 128.f) + 1e-6f);
                if (hh < 8) { x0 *= rstd * gq0; x1 *= rstd * gq1; x2 *= rstd * gq2; x3 *= rstd * gq3; }
                else { x0 *= rstd * gk0; x1 *= rstd * gk1; x2 *= rstd * gk2; x3 *= rstd * gk3; }
                if (row < NTOK) {
                    const int t = row & 2047, rr = t >> 6, cc = t & 63;
                    float sr, cr, sc_, cc_; sincosf((float)rr * invf, &sr, &cr); sincosf((float)cc * invf, &sc_, &cc_);
                    const float y0 = x0 * cr - x1 * sr, y1 = x1 * cr + x0 * sr, y2 = x2 * cc_ - x3 * sc_, y3 = x3 * cc_ + x2 * sc_;
                    x0 = y0; x1 = y1; x2 = y2; x3 = y3;
                }
                bf16_t* op;
                if (hh < 8) { const int b = row >> 11, t = row & 2047; const float qs = QSCALE * LOG2E; x0 *= qs; x1 *= qs; x2 *= qs; x3 *= qs;
                    op = Qp + ((size_t)(b * 8 + hh) * SEQ + t) * 128 + i; }
                else { int b, pos; if (row < NTOK) { b = row >> 11; pos = CTXL + (row & 2047); } else { b = (row - NTOK) >> 8; pos = (row - NTOK) & 255; }
                    op = Kp + ((size_t)(b * 2 + (hh - 8)) * KVLEN + pos) * 128 + i; }
                if (base + u * nhw + hw < NHR) { op[0] = f2bf1(x0); op[32] = f2bf1(x1); op[64] = f2bf1(x2); op[96] = f2bf1(x3); }
            }
        }
    }
    {
        bf16_t* QE = (bf16_t*)(P.ws + WS_QE); bf16_t* KE = (bf16_t*)(P.ws + WS_KE); bf16_t* KDT = (bf16_t*)(P.ws + WS_KDT);
        float* DEC = (float*)(P.ws + WS_DEC); bf16_t* VT = (bf16_t*)(P.ws + WS_VT); bf16_t* VTA = (bf16_t*)(P.ws + WS_VTA);
        LAS float* tot = (LAS float*)lds;
        LAS bf16_t* vt = (LAS bf16_t*)(lds + 4096);
        LAS bf16_t* va = (LAS bf16_t*)(lds + 4096 + 33792);
        const int d = tid & 127, part = tid >> 7;
        for (int item = blockIdx.x; item < NBATCH * 4 * 36; item += gridDim.x) {
            const int pc = item % 36, h = (item / 36) & 3, b = item / 144;
            const int row0 = pc < 4 ? NTOK + b * CTXL + pc * 64 : b * SEQ + (pc - 4) * 64;
            float g0[16], g1[16];
            {
                float gkf[16], gkb[16];
#pragma unroll
                for (int r = 0; r < 16; ++r) { gkf[r] = P.in[14][r * 512 + h * 128 + d]; gkb[r] = P.in[16][r * 512 + h * 128 + d]; }
                const float bf_ = P.in[15][h * 128 + d], bb_ = P.in[17][h * 128 + d];
#pragma unroll
                for (int i = 0; i < 16; ++i) {
                    const bf16_t* lr = proj + (size_t)(row0 + part * 16 + i) * INCP + C_LRF;
                    const u32x4 w0 = *(const u32x4*)lr, w1 = *(const u32x4*)(lr + 8), w2 = *(const u32x4*)(lr + 16), w3 = *(const u32x4*)(lr + 24);
                    float zf = bf_, zb = bb_;
#pragma unroll
                    for (int e = 0; e < 4; ++e) {
                        zf += __uint_as_float(w0[e] << 16) * gkf[2 * e] + __uint_as_float(w0[e] & 0xffff0000u) * gkf[2 * e + 1];
                        zf += __uint_as_float(w1[e] << 16) * gkf[8 + 2 * e] + __uint_as_float(w1[e] & 0xffff0000u) * gkf[8 + 2 * e + 1];
                        zb += __uint_as_float(w2[e] << 16) * gkb[2 * e] + __uint_as_float(w2[e] & 0xffff0000u) * gkb[2 * e + 1];
                        zb += __uint_as_float(w3[e] << 16) * gkb[8 + 2 * e] + __uint_as_float(w3[e] & 0xffff0000u) * gkb[8 + 2 * e + 1];
                    }
                    g0[i] = log_sigmoid_f(zf) * (1.f / 16.f); g1[i] = log_sigmoid_f(zb) * (1.f / 16.f);
                }
            }
            float run0 = 0.f, run1 = 0.f;
#pragma unroll
            for (int i = 0; i < 16; ++i) { run0 += g0[i]; g0[i] = run0; }
#pragma unroll
            for (int i = 15; i >= 0; --i) { run1 += g1[i]; g1[i] = run1; }
            tot[(0 * 4 + part) * 128 + d] = run0; tot[(1 * 4 + part) * 128 + d] = run1;
#pragma unroll
            for (int j = 0; j < 4; ++j) { const int chunk = tid + 512 * j, rr = chunk >> 5, sg = chunk & 31;
                *(LAS u32x4*)(vt + rr * 264 + sg * 8) = *(const u32x4*)(proj + (size_t)(row0 + rr) * INCP + C_BV + h * 256 + sg * 8); }
            if (h < 2) {
#pragma unroll
                for (int j = 0; j < 2; ++j) { const int chunk = tid + 512 * j, rr = chunk >> 4, sg = chunk & 15;
                    *(LAS u32x4*)(va + rr * 136 + sg * 8) = *(const u32x4*)(proj + (size_t)(row0 + rr) * INCP + C_AV + h * 128 + sg * 8); } }
            __syncthreads();
            float off0 = 0.f, off1 = 0.f, bt0 = 0.f, bt1 = 0.f;
#pragma unroll
            for (int p = 0; p < 4; ++p) { const float t0 = tot[p * 128 + d], t1 = tot[(4 + p) * 128 + d]; bt0 += t0; bt1 += t1; if (p < part) off0 += t0; if (p > part) off1 += t1; }
            const int ch0 = (0 * 8 + b) * 4 + h, ch1 = (1 * 8 + b) * 4 + h;
            unsigned kd0[8], kd1[8];
            bf16_t qraw[16], kraw[16];
#pragma unroll
            for (int i = 0; i < 16; ++i) { const bf16_t* pr = proj + (size_t)(row0 + part * 16 + i) * INCP + h * 128 + d; qraw[i] = pr[C_BQ]; kraw[i] = pr[C_BK]; }
#pragma unroll
            for (int i2 = 0; i2 < 8; ++i2) {
                float kdv0[2], kdv1[2];
#pragma unroll
                for (int u = 0; u < 2; ++u) {
                    const int i = 2 * i2 + u, c = part * 16 + i, pos = pc * 64 + c;
                    const float q = bf2f(qraw[i]) * QSCALE, k = bf2f(kraw[i]);
                    const float b0 = off0 + g0[i], b1 = off1 + g1[i];
                    const size_t o0 = ((size_t)ch0 * KVLEN + pos) * 128 + d, o1 = ((size_t)ch1 * KVLEN + pos) * 128 + d;
                    if (pc >= 4) { QE[o0] = f2bf1(q * __expf(b0)); QE[o1] = f2bf1(q * __expf(b1)); }
                    KE[o0] = f2bf1(k * __expf(-b0)); KE[o1] = f2bf1(k * __expf(-b1));
                    kdv0[u] = k * __expf(bt0 - b0); kdv1[u] = k * __expf(bt1 - b1);
                }
                kd0[i2] = cvt_pk_bf16(kdv0[0], kdv0[1]); kd1[i2] = cvt_pk_bf16(kdv1[0], kdv1[1]);
            }
            { u32x4* p0 = (u32x4*)(KDT + (((size_t)ch0 * 36 + pc) * 128 + d) * 64 + part * 16); p0[0] = (u32x4){kd0[0], kd0[1], kd0[2], kd0[3]}; p0[1] = (u32x4){kd0[4], kd0[5], kd0[6], kd0[7]};
              u32x4* p1 = (u32x4*)(KDT + (((size_t)ch1 * 36 + pc) * 128 + d) * 64 + part * 16); p1[0] = (u32x4){kd1[0], kd1[1], kd1[2], kd1[3]}; p1[1] = (u32x4){kd1[4], kd1[5], kd1[6], kd1[7]}; }
            if (part == 0) { DEC[((size_t)ch0 * 36 + pc) * 128 + d] = __expf(bt0); DEC[((size_t)ch1 * 36 + pc) * 128 + d] = __expf(bt1); }
            { const int e = tid & 255, half = tid >> 8; unsigned w[16];
#pragma unroll
              for (int i = 0; i < 16; ++i) w[i] = (unsigned)vt[(half * 32 + 2 * i) * 264 + e] | ((unsigned)vt[(half * 32 + 2 * i + 1) * 264 + e] << 16);
              u32x4* vp = (u32x4*)(VT + ((size_t)((b * 4 + h) * 256 + e)) * KVLEN + pc * 64 + half * 32);
              vp[0] = (u32x4){w[0], w[1], w[2], w[3]}; vp[1] = (u32x4){w[4], w[5], w[6], w[7]}; vp[2] = (u32x4){w[8], w[9], w[10], w[11]}; vp[3] = (u32x4){w[12], w[13], w[14], w[15]}; }
            if (h < 2) { const int dim = tid & 127, qt = tid >> 7; unsigned w[8];
#pragma unroll
                for (int i = 0; i < 8; ++i) w[i] = (unsigned)va[(qt * 16 + 2 * i) * 136 + dim] | ((unsigned)va[(qt * 16 + 2 * i + 1) * 136 + dim] << 16);
                u32x4* vp = (u32x4*)(VTA + ((size_t)((b * 2 + h) * 128 + dim)) * KVLEN + pc * 64 + qt * 16);
                vp[0] = (u32x4){w[0], w[1], w[2], w[3]}; vp[1] = (u32x4){w[4], w[5], w[6], w[7]}; }
            __syncthreads();
        }
    }
}

#define MFMA16(a, b, c) __builtin_amdgcn_mfma_f32_16x16x32_bf16((a), (b), (c), 0, 0, 0)
__device__ __forceinline__ void attn_item(const Params& P, int item, LAS unsigned char* lds, float mfix2) {
    const int tid = threadIdx.x, lane = tid & 63, wave = __builtin_amdgcn_readfirstlane(tid >> 6), r16 = lane & 15, q4 = lane >> 4;
    const int hp = item & 1, qb = (item >> 1) & 15, kvh = (item >> 5) & 1, b = item >> 6;
    const int head = kvh * 4 + hp * 2 + (wave >> 2), rw0 = (wave & 3) * 32, q0 = qb * 128;
    const bf16_t* Kb = (const bf16_t*)(P.ws + WS_KP) + (size_t)(b * 2 + kvh) * KVLEN * 128;
    const bf16_t* Vtb = (const bf16_t*)(P.ws + WS_VTA) + (size_t)(b * 2 + kvh) * 128 * KVLEN;
    bf16_t* mix = (bf16_t*)(P.ws + WS_MIX);
    LAS unsigned char* Pw = lds + 71680 + wave * 4608;
    bf16x8 qf[2][4];
    { const bf16_t* qbase = (const bf16_t*)(P.ws + WS_QP) + ((size_t)(b * 8 + head) * SEQ + q0 + rw0) * 128;
#pragma unroll
      for (int rb = 0; rb < 2; ++rb)
#pragma unroll
          for (int ks = 0; ks < 4; ++ks) qf[rb][ks] = *(const bf16x8*)(qbase + (rb * 16 + r16) * 128 + ks * 32 + q4 * 8); }
    const float psink = exp2f(P.in[13][head] * LOG2E - mfix2);
    f32x4 o[2][8]; float lsum[2][4];
#pragma unroll
    for (int rb = 0; rb < 2; ++rb) {
#pragma unroll
        for (int db = 0; db < 8; ++db) o[rb][db] = (f32x4){0.f, 0.f, 0.f, 0.f};
#pragma unroll
        for (int j = 0; j < 4; ++j) lsum[rb][j] = 0.f; }
    const int lt_first = qb == 0 ? 0 : (qb - 1) * 2, lt_last = (qb * 2 + 3) > 31 ? 31 : (qb * 2 + 3), ntiles = 4 + lt_last - lt_first + 1;
    const int kkey0 = tid >> 4, kseg = tid & 15, vdim0 = tid >> 3, vseg = tid & 7;
    u32x4 krA[2], vrA[2], krB[2], vrB[2];
#define ATT_POS0(i) ((i) < 4 ? (i) * 64 : CTXL + (lt_first + (i) - 4) * 64)
#define ATT_LOAD(i, kr, vr) do { const int _p = ATT_POS0(i); \
        kr[0] = *(const u32x4*)(Kb + (size_t)(_p + kkey0) * 128 + kseg * 8); kr[1] = *(const u32x4*)(Kb + (size_t)(_p + kkey0 + 32) * 128 + kseg * 8); \
        vr[0] = *(const u32x4*)(Vtb + (size_t)vdim0 * KVLEN + _p + vseg * 8); vr[1] = *(const u32x4*)(Vtb + (size_t)(vdim0 + 64) * KVLEN + _p + vseg * 8); } while (0)
#define ATT_STORE(bi, kr, vr) do { LAS unsigned char* _k = lds + (bi) * 17408; LAS unsigned char* _v = lds + 34816 + (bi) * 18432; \
        *(LAS u32x4*)(_k + kkey0 * 272 + kseg * 16) = kr[0]; *(LAS u32x4*)(_k + (kkey0 + 32) * 272 + kseg * 16) = kr[1]; \
        *(LAS u32x4*)(_v + vdim0 * 144 + vseg * 16) = vr[0]; *(LAS u32x4*)(_v + (vdim0 + 64) * 144 + vseg * 16) = vr[1]; } while (0)
    ATT_LOAD(0, krA, vrA); ATT_STORE(0, krA, vrA);
    ATT_LOAD(1, krA, vrA);
    __syncthreads();
    for (int i0 = 0; i0 < ntiles; i0 += 2) {
        { const int i = i0;
          if (i + 2 < ntiles) ATT_LOAD(i + 2, krB, vrB);
        const LAS unsigned char* kbuf = lds + (i & 1) * 17408; const LAS unsigned char* vbuf = lds + 34816 + (i & 1) * 18432;
        const int p0 = ATT_POS0(i); const int lt = lt_first + i - 4;
        const bool masked = (i >= 4) && (lt < qb * 2 || lt > qb * 2 + 1);
        const bool live = !masked || ((p0 - CTXL + 63 >= q0 + rw0 - 128) && (p0 - CTXL <= q0 + rw0 + 31 + 128));
        if (live) {
        f32x4 s[2][4];
#pragma unroll
        for (int rb = 0; rb < 2; ++rb)
#pragma unroll
            for (int cb = 0; cb < 4; ++cb) s[rb][cb] = (f32x4){0.f, 0.f, 0.f, 0.f};
#pragma unroll
        for (int ks = 0; ks < 4; ++ks)
#pragma unroll
            for (int cb = 0; cb < 4; ++cb) { const bf16x8 kf = *(const LAS bf16x8*)(kbuf + (cb * 16 + r16) * 272 + ks * 64 + q4 * 16);
#pragma unroll
                for (int rb = 0; rb < 2; ++rb) s[rb][cb] = MFMA16(qf[rb][ks], kf, s[rb][cb]); }
#pragma unroll
        for (int rb = 0; rb < 2; ++rb)
#pragma unroll
            for (int cb = 0; cb < 4; ++cb)
#pragma unroll
                for (int j = 0; j < 4; ++j) {
                    float p = exp2f(s[rb][cb][j] - mfix2);
                    if (masked) { const int dq = (q0 + rw0 + rb * 16 + q4 * 4 + j) - (p0 - CTXL + cb * 16 + r16); if (dq > 128 || dq < -128) p = 0.f; }
                    lsum[rb][j] += p;
                    *(LAS bf16_t*)(Pw + (rb * 16 + q4 * 4 + j) * 144 + (cb * 16 + r16) * 2) = f2bf1(p);
                }
        asm volatile("s_waitcnt lgkmcnt(0)" ::: "memory");
#pragma unroll
        for (int ks = 0; ks < 2; ++ks) { bf16x8 pf[2];
#pragma unroll
            for (int rb = 0; rb < 2; ++rb) pf[rb] = *(const LAS bf16x8*)(Pw + (rb * 16 + r16) * 144 + ks * 64 + q4 * 16);
#pragma unroll
            for (int db = 0; db < 8; ++db) { const bf16x8 vf = *(const LAS bf16x8*)(vbuf + (db * 16 + r16) * 144 + ks * 64 + q4 * 16);
#pragma unroll
                for (int rb = 0; rb < 2; ++rb) o[rb][db] = MFMA16(pf[rb], vf, o[rb][db]); } }
        }
        asm volatile("s_waitcnt lgkmcnt(0)" ::: "memory");

          ATT_STORE(1, krA, vrA);
          __syncthreads(); }
        { const int i = i0 + 1;
          if (i + 2 < ntiles) ATT_LOAD(i + 2, krA, vrA);
        const LAS unsigned char* kbuf = lds + (i & 1) * 17408; const LAS unsigned char* vbuf = lds + 34816 + (i & 1) * 18432;
        const int p0 = ATT_POS0(i); const int lt = lt_first + i - 4;
        const bool masked = (i >= 4) && (lt < qb * 2 || lt > qb * 2 + 1);
        const bool live = !masked || ((p0 - CTXL + 63 >= q0 + rw0 - 128) && (p0 - CTXL <= q0 + rw0 + 31 + 128));
        if (live) {
        f32x4 s[2][4];
#pragma unroll
        for (int rb = 0; rb < 2; ++rb)
#pragma unroll
            for (int cb = 0; cb < 4; ++cb) s[rb][cb] = (f32x4){0.f, 0.f, 0.f, 0.f};
#pragma unroll
        for (int ks = 0; ks < 4; ++ks)
#pragma unroll
            for (int cb = 0; cb < 4; ++cb) { const bf16x8 kf = *(const LAS bf16x8*)(kbuf + (cb * 16 + r16) * 272 + ks * 64 + q4 * 16);
#pragma unroll
                for (int rb = 0; rb < 2; ++rb) s[rb][cb] = MFMA16(qf[rb][ks], kf, s[rb][cb]); }
#pragma unroll
        for (int rb = 0; rb < 2; ++rb)
#pragma unroll
            for (int cb = 0; cb < 4; ++cb)
#pragma unroll
                for (int j = 0; j < 4; ++j) {
                    float p = exp2f(s[rb][cb][j] - mfix2);
                    if (masked) { const int dq = (q0 + rw0 + rb * 16 + q4 * 4 + j) - (p0 - CTXL + cb * 16 + r16); if (dq > 128 || dq < -128) p = 0.f; }
                    lsum[rb][j] += p;
                    *(LAS bf16_t*)(Pw + (rb * 16 + q4 * 4 + j) * 144 + (cb * 16 + r16) * 2) = f2bf1(p);
                }
        asm volatile("s_waitcnt lgkmcnt(0)" ::: "memory");
#pragma unroll
        for (int ks = 0; ks < 2; ++ks) { bf16x8 pf[2];
#pragma unroll
            for (int rb = 0; rb < 2; ++rb) pf[rb] = *(const LAS bf16x8*)(Pw + (rb * 16 + r16) * 144 + ks * 64 + q4 * 16);
#pragma unroll
            for (int db = 0; db < 8; ++db) { const bf16x8 vf = *(const LAS bf16x8*)(vbuf + (db * 16 + r16) * 144 + ks * 64 + q4 * 16);
#pragma unroll
                for (int rb = 0; rb < 2; ++rb) o[rb][db] = MFMA16(pf[rb], vf, o[rb][db]); } }
        }
        asm volatile("s_waitcnt lgkmcnt(0)" ::: "memory");

          if (i + 1 < ntiles) ATT_STORE(0, krB, vrB);
          __syncthreads(); }
    }
    LAS unsigned char* ob = lds + wave * 8704;
#pragma unroll
    for (int rb = 0; rb < 2; ++rb)
#pragma unroll
        for (int j = 0; j < 4; ++j) { float l = lsum[rb][j]; l += __shfl_xor(l, 1); l += __shfl_xor(l, 2); l += __shfl_xor(l, 4); l += __shfl_xor(l, 8);
            const float inv = 1.f / (l + psink);
#pragma unroll
            for (int db = 0; db < 8; ++db) *(LAS bf16_t*)(ob + (rb * 16 + q4 * 4 + j) * 272 + (db * 16 + r16) * 2) = f2bf1(o[rb][db][j] * inv); }
    asm volatile("s_waitcnt lgkmcnt(0)" ::: "memory");
#pragma unroll
    for (int i = 0; i < 8; ++i) { const int c = lane + 64 * i, row = c >> 4, seg = c & 15;
        *(u32x4*)(mix + (size_t)(b * SEQ + q0 + rw0 + row) * D + head * 128 + seg * 8) = *(const LAS u32x4*)(ob + row * 272 + seg * 16); }
    __syncthreads();
#undef ATT_POS0
#undef ATT_LOAD
#undef ATT_STORE
}

__device__ __forceinline__ void gla_scan_item(const Params& P, int item, LAS unsigned char* lds) {
    const int tid = threadIdx.x, lane = tid & 63, wave = __builtin_amdgcn_readfirstlane(tid >> 6), r16 = lane & 15, q4 = lane >> 4;
    const int es = item & 3, h = (item >> 2) & 3, b = (item >> 4) & 7, dir = item >> 7;
    const int ch = (dir * 8 + b) * 4 + h;
    const bf16_t* QE = (const bf16_t*)(P.ws + WS_QE); const bf16_t* KE = (const bf16_t*)(P.ws + WS_KE); const bf16_t* KDT = (const bf16_t*)(P.ws + WS_KDT);
    const float* DEC = (const float*)(P.ws + WS_DEC); const bf16_t* VT = (const bf16_t*)(P.ws + WS_VT) + ((size_t)((b * 4 + h) * 256 + es * 64)) * KVLEN;
    float* od = (float*)(P.ws + WS_X) + (size_t)dir * NTOK * 1024;
    LAS unsigned char* Al = lds;
    LAS unsigned char* ST0 = lds + 9216; LAS unsigned char* ST1 = ST0 + 17408;
    LAS unsigned char* Lq = lds + 44032;
    LAS unsigned char* Lk = Lq + 17408;
    LAS unsigned char* Ld = Lk + 17408;
    LAS unsigned char* Lv = Ld + 18432;
    for (int i = tid; i < 17408 / 4; i += 512) ((LAS unsigned*)ST0)[i] = 0u;
    f32x4 sreg[4];
#pragma unroll
    for (int eb = 0; eb < 4; ++eb) sreg[eb] = (f32x4){0.f, 0.f, 0.f, 0.f};
    const int cbk = wave >> 1, hb = (wave & 1) * 2;
    const int qrow = tid >> 4, qseg = tid & 15, drow = tid >> 3, dseg = tid & 7;
    u32x4 rq[2], rk[2], rd[2], rv; f32x4 decn;
#define GLA_PC(n) (dir ? ((n) < 4 ? 3 - (n) : 39 - (n)) : (n))
#define GLA_LOAD(n) do { const int _pc = GLA_PC(n); \
        if (_pc >= 4) { const bf16_t* _q = QE + ((size_t)ch * KVLEN + _pc * 64) * 128 + qseg * 8; const bf16_t* _k = KE + ((size_t)ch * KVLEN + _pc * 64) * 128 + qseg * 8; \
            rq[0] = *(const u32x4*)(_q + qrow * 128); rq[1] = *(const u32x4*)(_q + (qrow + 32) * 128); rk[0] = *(const u32x4*)(_k + qrow * 128); rk[1] = *(const u32x4*)(_k + (qrow + 32) * 128); } \
        const bf16_t* _d = KDT + ((size_t)ch * 36 + _pc) * 128 * 64 + dseg * 8; rd[0] = *(const u32x4*)(_d + drow * 64); rd[1] = *(const u32x4*)(_d + (drow + 64) * 64); \
        rv = *(const u32x4*)(VT + (size_t)drow * KVLEN + _pc * 64 + dseg * 8); \
        decn = *(const f32x4*)(DEC + ((size_t)ch * 36 + _pc) * 128 + wave * 16 + q4 * 4); } while (0)
#define GLA_STORE(n) do { const int _pc = GLA_PC(n); \
        if (_pc >= 4) { *(LAS u32x4*)(Lq + qrow * 272 + qseg * 16) = rq[0]; *(LAS u32x4*)(Lq + (qrow + 32) * 272 + qseg * 16) = rq[1]; \
                        *(LAS u32x4*)(Lk + qrow * 272 + qseg * 16) = rk[0]; *(LAS u32x4*)(Lk + (qrow + 32) * 272 + qseg * 16) = rk[1]; } \
        *(LAS u32x4*)(Ld + drow * 144 + dseg * 16) = rd[0]; *(LAS u32x4*)(Ld + (drow + 64) * 144 + dseg * 16) = rd[1]; *(LAS u32x4*)(Lv + drow * 144 + dseg * 16) = rv; } while (0)
    GLA_LOAD(0); GLA_STORE(0);
    f32x4 dec4 = decn;
    __syncthreads();
    for (int n = 0; n < 36; ++n) {
        const int pc = GLA_PC(n);
        LAS unsigned char* STc = (n & 1) ? ST1 : ST0; LAS unsigned char* STn = (n & 1) ? ST0 : ST1;
        if (n + 1 < 36) GLA_LOAD(n + 1);
        if (pc >= 4) {
            bf16x8 qf[4];
#pragma unroll
            for (int ks = 0; ks < 4; ++ks) qf[ks] = *(const LAS bf16x8*)(Lq + (cbk * 16 + r16) * 272 + ks * 64 + q4 * 16);
#pragma unroll
            for (int t2 = 0; t2 < 2; ++t2) { const int sbk = hb + t2;
                f32x4 a = (f32x4){0.f, 0.f, 0.f, 0.f};
#pragma unroll
                for (int ks = 0; ks < 4; ++ks) { const bf16x8 kf = *(const LAS bf16x8*)(Lk + (sbk * 16 + r16) * 272 + ks * 64 + q4 * 16); a = MFMA16(qf[ks], kf, a); }
#pragma unroll
                for (int j = 0; j < 4; ++j) { const int c = cbk * 16 + q4 * 4 + j, s_ = sbk * 16 + r16; const bool keep = dir ? (s_ >= c) : (s_ <= c);
                    *(LAS bf16_t*)(Al + c * 144 + s_ * 2) = f2bf1(keep ? a[j] : 0.f); } }
            __syncthreads();
#pragma unroll
            for (int t2 = 0; t2 < 2; ++t2) { const int ebk = hb + t2; f32x4 ov = (f32x4){0.f, 0.f, 0.f, 0.f};
#pragma unroll
                for (int ks = 0; ks < 2; ++ks) { const bf16x8 af = *(const LAS bf16x8*)(Al + (cbk * 16 + r16) * 144 + ks * 64 + q4 * 16);
                    const bf16x8 vfo = *(const LAS bf16x8*)(Lv + (ebk * 16 + r16) * 144 + ks * 64 + q4 * 16); ov = MFMA16(af, vfo, ov); }
#pragma unroll
                for (int ks = 0; ks < 4; ++ks) { const bf16x8 sf = *(const LAS bf16x8*)(STc + (ebk * 16 + r16) * 272 + ks * 64 + q4 * 16); ov = MFMA16(qf[ks], sf, ov); }
#pragma unroll
                for (int j = 0; j < 4; ++j) od[(size_t)(b * SEQ + (pc - 4) * 64 + cbk * 16 + q4 * 4 + j) * 1024 + h * 256 + es * 64 + ebk * 16 + r16] = ov[j]; }
        }
        { bf16x8 kdf[2];
#pragma unroll
          for (int ks = 0; ks < 2; ++ks) kdf[ks] = *(const LAS bf16x8*)(Ld + (wave * 16 + r16) * 144 + ks * 64 + q4 * 16);
#pragma unroll
          for (int eb = 0; eb < 4; ++eb) { f32x4 sv = sreg[eb] * dec4;
#pragma unroll
              for (int ks = 0; ks < 2; ++ks) { const bf16x8 vf = *(const LAS bf16x8*)(Lv + (eb * 16 + r16) * 144 + ks * 64 + q4 * 16); sv = MFMA16(kdf[ks], vf, sv); }
              sreg[eb] = sv;
              u32x2 w; w.x = cvt_pk_bf16(sv[0], sv[1]); w.y = cvt_pk_bf16(sv[2], sv[3]);
              *(LAS u32x2*)(STn + (eb * 16 + r16) * 272 + (wave * 16 + q4 * 4) * 2) = w; } }
        __syncthreads();
        if (n + 1 < 36) { GLA_STORE(n + 1); dec4 = decn; }
        __syncthreads();
    }
#undef GLA_PC
#undef GLA_LOAD
#undef GLA_STORE
}

__device__ __forceinline__ void gla_out_phase(const Params& P) {
    const int tid = threadIdx.x, lane = tid & 63, wave = tid >> 6;
    const bf16_t* proj = (const bf16_t*)(P.ws + WS_PROJ);
    const float* of = (const float*)(P.ws + WS_X); const float* ob = of + (size_t)NTOK * 1024;
    bf16_t* mix = (bf16_t*)(P.ws + WS_MIX);
    const f32x4 gn = *(const f32x4*)(P.in[18] + lane * 4);
    for (int idx = blockIdx.x * 8 + wave; idx < NTOK * 4; idx += gridDim.x * 8) {
        const int row = idx >> 2, h = idx & 3; const size_t off = (size_t)row * 1024 + h * 256 + lane * 4;
        const f32x4 o = *(const f32x4*)(of + off) + *(const f32x4*)(ob + off);
        const float ss = wave_sum((o[0] * o[0] + o[1] * o[1]) + (o[2] * o[2] + o[3] * o[3]));
        const float rstd = rsqrtf(ss * (1.f / 256.f) + 1e-6f);
        const u32x2 gw = *(const u32x2*)(proj + (size_t)row * INCP + C_BG + h * 256 + lane * 4);
        const float g0 = __uint_as_float(gw.x << 16), g1 = __uint_as_float(gw.x & 0xffff0000u), g2 = __uint_as_float(gw.y << 16), g3 = __uint_as_float(gw.y & 0xffff0000u);
        u32x2 w; w.x = cvt_pk_bf16(o[0] * rstd * gn[0] * silu_f(g0), o[1] * rstd * gn[1] * silu_f(g1)); w.y = cvt_pk_bf16(o[2] * rstd * gn[2] * silu_f(g2), o[3] * rstd * gn[3] * silu_f(g3));
        *(u32x2*)(mix + (size_t)row * D + 1024 + h * 256 + lane * 4) = w;
    }
}

__global__ void __launch_bounds__(512, 2) mega(Params P) {
    extern __shared__ __attribute__((aligned(16))) unsigned char smem[];
    LAS unsigned char* lds = (LAS unsigned char*)smem;
    cg::grid_group grid = cg::this_grid();
    unsigned char* ws = P.ws;
    float* mod = (float*)(ws + WS_MOD);
    bf16_t* x16 = (bf16_t*)(ws + WS_X);
    bf16_t* hbuf = (bf16_t*)(ws + WS_H);
    bf16_t* mix = (bf16_t*)(ws + WS_MIX);
#ifdef ONLY_PH
#define RUN_PH(ph) if ((ph) == ONLY_PH && P.ph_lo <= (ph) && (ph) < P.ph_hi)
#else
#define RUN_PH(ph) if (P.ph_lo <= (ph) && (ph) < P.ph_hi)
#endif
#define SYNC_PH(ph) do { if ((ph) > P.ph_lo && (ph) < P.ph_hi) xcd_barrier(xbar); } while (0)
    if (threadIdx.x < 16) ((LAS unsigned*)(lds + 131072))[threadIdx.x] = 0u;
    __syncthreads();
    XcdBarrier xbar = xcd_barrier_post((unsigned*)(ws + WS_BAR), (volatile LAS unsigned*)(lds + 131072));
    if (P.ph_lo < 0) grid.sync();
    const float* mod0 = mod; const float* mod1 = mod + (size_t)9 * 12288;
    RUN_PH(0) { ada_phase(P, lds); __syncthreads(); weights_phase(P, lds); }
    SYNC_PH(1);
    RUN_PH(1) norm_phase(P.in[0], P.in[2], NROWS, P.in[6], mod0, 0, 1, hbuf, (const bf16_t*)(ws + WS_WIN), (bf16_t*)(ws + WS_PROJ), nullptr, lds);
    SYNC_PH(2);
    RUN_PH(2) { GemmP g = gemm_std(hbuf, D, ws + WS_WIN, D, D, NTOK / 256, INCP / 256); g.extra = 64; g.out = ws + WS_PROJ; g.ldc = INCP; g.o_pm = (size_t)256 * INCP; gemm_phase(lds, g); }
    SYNC_PH(3);
    RUN_PH(3) prep_phase(P, lds);
    SYNC_PH(4);
    RUN_PH(4) {
        float gq = fmaxf(fabsf(P.in[11][threadIdx.x & 63]), fabsf(P.in[11][64 + (threadIdx.x & 63)])), gk = fmaxf(fabsf(P.in[12][threadIdx.x & 63]), fabsf(P.in[12][64 + (threadIdx.x & 63)]));
#pragma unroll
        for (int o = 1; o < 64; o <<= 1) { gq = fmaxf(gq, __shfl_xor(gq, o)); gk = fmaxf(gk, __shfl_xor(gk, o)); }
        const float mfix2 = 11.313708498984761f * gq * gk * LOG2E;
        for (int it = blockIdx.x; it < 512; it += gridDim.x) attn_item(P, it, lds, mfix2);
        for (int it = blockIdx.x; it < 256; it += gridDim.x) gla_scan_item(P, it, lds);
    }
    SYNC_PH(5);
    RUN_PH(5) gla_out_phase(P);
    SYNC_PH(6);
    RUN_PH(6) { GemmP g = gemm_std(mix, D, ws + WS_WOUT, D, D, NTOK / 256, D / 256); g.mode = 1; g.out = x16; g.out16 = 1; g.ldc = D; g.o_pm = (size_t)256 * D; g.base = P.in[0]; g.gate = mod0 + 2 * 2048; gemm_phase(lds, g); }
    SYNC_PH(7);
    RUN_PH(7) norm_phase(nullptr, nullptr, NTOK, P.in[7], mod0, 3, 4, hbuf, nullptr, nullptr, x16);
    SYNC_PH(8);
    RUN_PH(8) { GemmP g = gemm_std(hbuf, D, ws + WS_W1, D, D, NTOK / 256, DFF / 256); g.act = 1; g.out = ws + WS_HID; g.ldc = DFF; g.o_pm = (size_t)256 * DFF; gemm_phase(lds, g); }
    SYNC_PH(9);
    RUN_PH(9) { GemmP g = gemm_std(ws + WS_HID, DFF, ws + WS_W2, DFF, DFF, NTOK / 256, D / 256); g.mode = 1; g.out = x16; g.out16 = 1; g.ldc = D; g.o_pm = (size_t)256 * D; g.base = (const float*)x16; g.base16 = 1; g.gate = mod0 + 5 * 2048; gemm_phase(lds, g); }
    SYNC_PH(10);
    RUN_PH(10) norm_pair_phase(x16, P.in[6] + D, mod1, hbuf);
    SYNC_PH(11);
    RUN_PH(11) { GemmP g = gemm_std(ws + WS_CMA, 256, hbuf, D, 256, 2, 8); g.nB = 64; g.b_bs_hi = (size_t)SEQ * D * 2; g.b_bs_lo = 256 * 2; g.act = 2;
        g.out = ws + WS_GT; g.ldc = 2048; g.o_bs_hi = (size_t)2048 * 2048; g.o_bs_lo = (size_t)256 * 2048; g.o_pm = 0; gemm_phase(lds, g); }
    SYNC_PH(12);
    RUN_PH(12) { GemmP g = gemm_std(ws + WS_CN, 2048, ws + WS_GT, 2048, 2048, 8, 8); g.nB = 8; g.b_bs_lo = (size_t)2048 * 2048 * 2;
        g.out = mix; g.ldc = D; g.o_bs_lo = (size_t)SEQ * D; g.o_pm = (size_t)256 * D; g.scale = 0.0013810679320049757f; gemm_phase(lds, g); }
    SYNC_PH(13);
    RUN_PH(13) { GemmP g = gemm_std(mix, D, ws + WS_CW, D, D, NTOK / 256, D / 256); g.mode = 1; g.out = x16; g.out16 = 1; g.ldc = D; g.o_pm = (size_t)256 * D; g.base = (const float*)x16; g.base16 = 1; g.gate = mod1 + 2 * 2048; g.bias = P.in[21]; gemm_phase(lds, g); }
    SYNC_PH(14);
    RUN_PH(14) norm_phase(nullptr, nullptr, NTOK, P.in[7] + D, mod1, 3, 4, hbuf, nullptr, nullptr, x16);
    SYNC_PH(15);
    RUN_PH(15) { GemmP g = gemm_std(hbuf, D, ws + WS_W1 + (size_t)DFF * D * 2, D, D, NTOK / 256, DFF / 256); g.act = 1; g.out = ws + WS_HID; g.ldc = DFF; g.o_pm = (size_t)256 * DFF; gemm_phase(lds, g); }
    SYNC_PH(16);
    RUN_PH(16) { GemmP g = gemm_std(ws + WS_HID, DFF, ws + WS_W2 + (size_t)DFF * D * 2, DFF, DFF, NTOK / 256, D / 256); g.mode = 1; g.out = P.out; g.ldc = D; g.o_pm = (size_t)256 * D; g.base = (const float*)x16; g.base16 = 1; g.gate = mod1 + 5 * 2048; gemm_phase(lds, g); }
}

extern "C" void kernel_launch(void* const* d_in, const int* in_sizes, int n_in, void* d_out, int out_size, void* d_ws, size_t ws_size, hipStream_t stream) {
    static int grid = 0;
    if (grid == 0) {
        if (n_in != 22 || out_size != NTOK * D || ws_size < WS_TOTAL) { fprintf(stderr, "kernel_launch: unexpected shapes (n_in %d, out %d, ws %zu < %zu)\n", n_in, out_size, ws_size, (size_t)WS_TOTAL); grid = -1; return; }
        int dev = 0, cus = 0, per_cu = 0;
        hipGetDevice(&dev); hipDeviceGetAttribute(&cus, hipDeviceAttributeMultiprocessorCount, dev);
        if (hipFuncSetAttribute((const void*)mega, hipFuncAttributeMaxDynamicSharedMemorySize, LDS_BYTES) != hipSuccess) { fprintf(stderr, "kernel_launch: hipFuncSetAttribute failed\n"); grid = -1; return; }
        if (hipOccupancyMaxActiveBlocksPerMultiprocessor(&per_cu, (const void*)mega, 512, LDS_BYTES) != hipSuccess || per_cu < 1) { fprintf(stderr, "kernel_launch: occupancy query failed (%d)\n", per_cu); per_cu = 1; (void)hipGetLastError(); }
        grid = cus * 1;
        if (grid % 8 != 0 || grid < 64) { fprintf(stderr, "kernel_launch: unexpected CU count %d\n", cus); }
    }
    if (grid < 0) return;
    if (hipMemsetAsync((char*)d_ws + WS_BAR, 0, XCD_BAR_WORDS * 4, stream) != hipSuccess) { fprintf(stderr, "kernel_launch: memset of barrier words failed\n"); return; }
    Params p{};
    for (int i = 0; i < 22; ++i) p.in[i] = (const float*)d_in[i];
    p.out = (float*)d_out; p.ws = (unsigned char*)d_ws; p.ph_lo = 0; p.ph_hi = NPH;
    void* args[] = {&p};
    hipError_t e = hipLaunchCooperativeKernel((const void*)mega, dim3(grid), dim3(512), args, LDS_BYTES, stream);
    if (e != hipSuccess) fprintf(stderr, "cooperative launch failed: %s (grid %d)\n", hipGetErrorString(e), grid);
}
```

```cpp
#include <hip/hip_runtime.h>
#include <hip/hip_cooperative_groups.h>
#include <cstdio>
#include <cstdint>
namespace cg = cooperative_groups;

#define LAS __attribute__((address_space(3)))
typedef unsigned short bf16_t;
typedef short bf16x8 __attribute__((ext_vector_type(8)));
typedef float f32x4 __attribute__((ext_vector_type(4)));
typedef float f32x2 __attribute__((ext_vector_type(2)));
typedef unsigned u32x4 __attribute__((ext_vector_type(4)));
typedef unsigned u32x2 __attribute__((ext_vector_type(2)));

constexpr int D = 2048, NBATCH = 8, SEQ = 2048, CTXL = 256, NTOK = NBATCH * SEQ, NCTX = NBATCH * CTXL, NROWS = NTOK + NCTX;
constexpr int INC = 4640, INCP = 4864, DFF = 8192, KVLEN = SEQ + CTXL;
constexpr int C_AQ = 0, C_AK = 1024, C_AV = 1280, C_BQ = 1536, C_BK = 2048, C_BV = 2560, C_BG = 3584, C_LRF = 4608, C_LRB = 4624;
constexpr int LDS_BYTES = 131072 + 64;
constexpr int NPH = 17;

constexpr size_t WS_WIN = 0;
constexpr size_t WS_WOUT = WS_WIN + (size_t)INCP * D * 2;
constexpr size_t WS_CW = WS_WOUT + (size_t)D * D * 2;
constexpr size_t WS_W1 = WS_CW + (size_t)D * D * 2;
constexpr size_t WS_W2 = WS_W1 + (size_t)2 * DFF * D * 2;
constexpr size_t WS_CN = WS_W2 + (size_t)2 * DFF * D * 2;
constexpr size_t WS_CMA = WS_CN + (size_t)2048 * 4096 * 2;
constexpr size_t WS_MOD = WS_CMA + (size_t)512 * 256 * 2;
constexpr size_t WS_X = WS_MOD + (size_t)2 * 9 * 12288 * 4;
constexpr size_t WS_H = WS_X + (size_t)NTOK * D * 4;
constexpr size_t WS_MIX = WS_H + (size_t)NROWS * D * 2;
constexpr size_t WS_BIG = WS_MIX + (size_t)NTOK * D * 2;
constexpr size_t WS_PROJ = WS_BIG;
constexpr size_t WS_QP = WS_PROJ + (size_t)NROWS * INCP * 2;
constexpr size_t WS_KP = WS_QP + (size_t)NBATCH * 8 * SEQ * 128 * 2;
constexpr size_t WS_VTA = WS_KP + (size_t)NBATCH * 2 * KVLEN * 128 * 2;
constexpr size_t WS_QE = WS_VTA + (size_t)NBATCH * 2 * 128 * KVLEN * 2;
constexpr size_t WS_VT = WS_QE + (size_t)64 * KVLEN * 128 * 2;
constexpr size_t WS_DEC = WS_VT + (size_t)NBATCH * 4 * 256 * KVLEN * 2;
constexpr size_t WS_END = WS_DEC + (size_t)64 * 36 * 128 * 4;
constexpr size_t WS_KE = WS_H;
constexpr size_t WS_KDT = WS_H + (size_t)64 * KVLEN * 128 * 2;
constexpr size_t WS_HID = WS_BIG;
constexpr size_t WS_GT = WS_BIG;
static_assert(WS_HID + (size_t)NTOK * DFF * 2 <= WS_END, "hid overlay");
static_assert(WS_KDT + (size_t)64 * 36 * 128 * 64 * 2 <= WS_MIX, "KE/KDT overlay");
constexpr size_t WS_BAR = WS_END;
constexpr size_t WS_TOTAL = WS_BAR + 16384;
static_assert(WS_BAR % 256 == 0 && WS_TOTAL <= (size_t)805306368, "workspace");

struct Params { const float* in[22]; float* out; unsigned char* ws; int ph_lo, ph_hi; };

__device__ __forceinline__ float bf2f(bf16_t h) { return __uint_as_float(((unsigned)h) << 16); }
typedef __bf16 bf16v2_t __attribute__((ext_vector_type(2)));
__device__ __forceinline__ unsigned cvt_pk_bf16(float lo, float hi) { const f32x2 v = {lo, hi}; const bf16v2_t b = __builtin_convertvector(v, bf16v2_t); return __builtin_bit_cast(unsigned, b); }
__device__ __forceinline__ bf16_t f2bf1(float x) { return (bf16_t)(cvt_pk_bf16(x, 0.f) & 0xffffu); }
__device__ __forceinline__ float wave_sum(float v) {
#pragma unroll
    for (int o = 1; o < 64; o <<= 1) v += __shfl_xor(v, o);
    return v;
}
__device__ __forceinline__ float silu_f(float x) { return x / (1.f + __expf(-x)); }

constexpr int BM = 256, BK = 64, HALF = 128, HTB = HALF * BK * 2, NXCD = 8, WGM = 8;
__device__ __forceinline__ int lds_byte(int r, int c) { const int st = (r >> 4) * 2 + (c >> 5), rr = r & 15, cc = c & 31, ob = rr * 64 + cc * 2; return st * 1024 + (ob ^ (((ob >> 9) & 1) << 5)); }
__device__ __forceinline__ void stage_rc(int b, int& R, int& C) { const int st = b / 1024, sb = b % 1024, swz = sb ^ (((sb >> 9) & 1) << 5); R = (st >> 1) * 16 + swz / 64; C = (st & 1) * 32 + (swz % 64) / 2; }
__device__ __forceinline__ int perm32(int rho) { const int n = rho >> 4, i = rho & 15; return 8 * (i >> 2) + 4 * n + (i & 3); }

struct Unit { int pm, pn, pb; };
struct GemmP {
    const char* A; const char* B;
    int lda, ldb, K;
    int nM, nN, nB;
    int extra;
    size_t b_bs_hi, b_bs_lo;
    int mode;
    int act;
    float scale;
    void* out; int ldc;
    size_t o_bs_hi, o_bs_lo, o_pm;
    const float* base; const float* gate; const float* bias;
    int base16, out16;
};

__device__ __forceinline__ bool gemm_next(const GemmP& g, int i, Unit& u) {
    if (g.act == 2) {
        const int L2 = i * (int)gridDim.x + (int)blockIdx.x; if (L2 >= g.nB * 9) return false;
        u.pb = L2 / 9; const int r = L2 - u.pb * 9; u.pm = r < 5 ? 0 : 1; u.pn = r < 5 ? r : r - 1; return true; }
    const int nwg = g.nM * g.nN; const int L = i * (int)gridDim.x + (int)blockIdx.x; if (L >= nwg * g.nB + g.extra) return false;
    if (L >= nwg * g.nB) { const int q = L - nwg * g.nB, r = q & 7; u.pb = 0; u.pm = g.nM + (q >> 3); u.pn = r < 2 ? 4 + r : 6 + r; return true; }
    u.pb = L / nwg; int wgid = L - u.pb * nwg;
    { const int q = nwg / NXCD, r = nwg % NXCD, xcd = wgid % NXCD, off = wgid / NXCD; wgid = (xcd < r ? xcd * (q + 1) : r * (q + 1) + (xcd - r) * q) + off; }
    const int nig = WGM * g.nN, gid = wgid / nig, fm = gid * WGM, gsz = (g.nM - fm) < WGM ? (g.nM - fm) : WGM;
    u.pm = fm + ((wgid % nig) % gsz); u.pn = (wgid % nig) / gsz; return true;
}

__device__ __forceinline__ void gemm_epi(const GemmP& g, const f32x4 (&acc)[2][2][4][2], const Unit& u, int wr, int wc, int fr, int fq) {
    const size_t obase = (size_t)(u.pb >> 3) * g.o_bs_hi + (size_t)(u.pb & 7) * g.o_bs_lo + (size_t)u.pm * g.o_pm + (size_t)u.pn * 256;
    const int rl0 = wr * 64 + fr;
    if (g.mode == 0) {
        bf16_t* O = (bf16_t*)g.out + obase + wc * 32 + 8 * fq;
        const float sc = g.scale; const bool act = g.act == 1;
        const bool cd = g.act == 2; const bool cd_first = cd && u.pn == 4 && wc == 0 && fq == 0;
        if (cd && ((u.pm == 0 && u.pn > 4) || (u.pm == 1 && u.pn < 4))) return;
#pragma unroll
        for (int ai = 0; ai < 2; ++ai)
#pragma unroll
            for (int m = 0; m < 4; ++m) { bf16_t* rowp = O + (size_t)(rl0 + ai * HALF + m * 16) * g.ldc;
#pragma unroll
                for (int bj = 0; bj < 2; ++bj) { f32x4 v0 = acc[ai][bj][m][0], v1 = acc[ai][bj][m][1];
                    if (act) {
#pragma unroll
                        for (int j = 0; j < 4; ++j) { const float a = fmaxf(v0[j], 0.f), b = fmaxf(v1[j], 0.f); v0[j] = a * a; v1[j] = b * b; } }
                    v0 = v0 * sc; v1 = v1 * sc;
                    u32x4 w; w.x = cvt_pk_bf16(v0[0], v0[1]); w.y = cvt_pk_bf16(v0[2], v0[3]); w.z = cvt_pk_bf16(v1[0], v1[1]); w.w = cvt_pk_bf16(v1[2], v1[3]);
                    if (!cd) *(u32x4*)(rowp + bj * HALF) = w;
                    else if (u.pm == 0) { if (u.pn < 4) *(u32x4*)(rowp + bj * HALF) = w; else if (cd_first && bj == 0) rowp[0] = (bf16_t)(w.x & 0xffffu); }
                    else { if (cd_first && bj == 0) { rowp[1] = (bf16_t)(w.x >> 16); *(unsigned*)(rowp + 2) = w.y; *(u32x2*)(rowp + 4) = (u32x2){w.z, w.w}; } else *(u32x4*)(rowp + bj * HALF) = w; } } }
    } else {
        const int cl0 = wc * 32 + 4 * fq, colg = u.pn * 256 + cl0;
        const float* gate = g.gate + (size_t)(u.pm >> 3) * 12288 + colg;
        f32x4 gv[2][2], bv[2][2];
#pragma unroll
        for (int bj = 0; bj < 2; ++bj)
#pragma unroll
            for (int n = 0; n < 2; ++n) { gv[bj][n] = *(const f32x4*)(gate + bj * HALF + n * 16);
                bv[bj][n] = g.bias ? *(const f32x4*)(g.bias + colg + bj * HALF + n * 16) : (f32x4){0.f, 0.f, 0.f, 0.f}; }
        float* outp = (float*)g.out;
#pragma unroll
        for (int ai = 0; ai < 2; ++ai) {
            u32x2 braw[4][2][2];
            if (g.base16) {
#pragma unroll
                for (int m = 0; m < 4; ++m) { const size_t off = obase + (size_t)(rl0 + ai * HALF + m * 16) * g.ldc + cl0;
#pragma unroll
                    for (int bj = 0; bj < 2; ++bj)
#pragma unroll
                        for (int n = 0; n < 2; ++n) braw[m][bj][n] = *(const u32x2*)((const bf16_t*)g.base + off + bj * HALF + n * 16); } }
#pragma unroll
            for (int m = 0; m < 4; ++m) { const size_t off = obase + (size_t)(rl0 + ai * HALF + m * 16) * g.ldc + cl0;
#pragma unroll
                for (int bj = 0; bj < 2; ++bj)
#pragma unroll
                    for (int n = 0; n < 2; ++n) { const size_t o2 = off + bj * HALF + n * 16; f32x4 bs;
                        if (g.base16) { const u32x2 w = braw[m][bj][n]; bs = (f32x4){__uint_as_float(w.x << 16), __uint_as_float(w.x & 0xffff0000u), __uint_as_float(w.y << 16), __uint_as_float(w.y & 0xffff0000u)}; }
                        else bs = *(const f32x4*)(g.base + o2);
                        const f32x4 r = bs + gv[bj][n] * (acc[ai][bj][m][n] + bv[bj][n]);
                        if (g.out16) { u32x2 w; w.x = cvt_pk_bf16(r[0], r[1]); w.y = cvt_pk_bf16(r[2], r[3]); *(u32x2*)((bf16_t*)g.out + o2) = w; }
                        else *(f32x4*)(outp + o2) = r; } }
            asm volatile("" ::: "memory"); }
    }
}

__device__ __forceinline__ void gemm_phase(LAS unsigned char* lds, const GemmP& g) {
    const int tid = threadIdx.x, wid = __builtin_amdgcn_readfirstlane(tid >> 6), lane = tid & 63, wr = wid >> 2, wc = wid & 3, fr = lane & 15, fq = lane >> 4;
    const int K = g.K, nt = K / BK; const bool perm = (g.mode == 0);
    unsigned voffA[2], voffB[2];
#pragma unroll
    for (int i = 0; i < 2; ++i) { int R, C; stage_rc(tid * 16 + i * 8192, R, C); const int Rb = perm ? ((R & ~31) + perm32(R & 31)) : R;
        voffA[i] = (unsigned)(R * g.lda + C) * 2u; voffB[i] = (unsigned)(Rb * g.ldb + C) * 2u; }
    const size_t kstep = (size_t)(BK * 2);
    const size_t hstepA = (size_t)HALF * g.lda * 2, hstepB = (size_t)HALF * g.ldb * 2;
    const size_t tstepA = 2 * hstepA, tstepB = 2 * hstepB;
    const unsigned ldsw = (unsigned)wid * 1024u;
    const int aoff = lds_byte(wr * 64 + fr, fq * 8), boff = lds_byte(wc * 32 + fr, fq * 8);
#define PG8_SA(b, h) (((b) * 2 + (h)) * HTB)
#define PG8_SB(b, h) ((4 + (b) * 2 + (h)) * HTB)
#define PG8_STAGE(bufoff, gbase, voff) do { const unsigned long long _u = (unsigned long long)(gbase); \
        const char* _gb = (const char*)(((unsigned long long)(unsigned)__builtin_amdgcn_readfirstlane((int)(unsigned)(_u >> 32)) << 32) | (unsigned long long)(unsigned)__builtin_amdgcn_readfirstlane((int)(unsigned)_u)); \
        _Pragma("unroll") for (int _i = 0; _i < 2; ++_i) \
        __builtin_amdgcn_global_load_lds((const unsigned*)(_gb + (voff)[_i]), (LAS unsigned*)(lds + (bufoff) + ldsw + _i * 8192), 16, 0, 0); } while (0)
#define PG8_LDA(dst, b, h) do { _Pragma("unroll") for (int m = 0; m < 4; ++m) _Pragma("unroll") for (int k = 0; k < 2; ++k) dst[m][k] = *(const LAS bf16x8*)(lds + PG8_SA(b, h) + aoff + m * 2048 + k * 1024); } while (0)
#define PG8_LDB(dst, b, h) do { _Pragma("unroll") for (int n = 0; n < 2; ++n) _Pragma("unroll") for (int k = 0; k < 2; ++k) dst[n][k] = *(const LAS bf16x8*)(lds + PG8_SB(b, h) + boff + n * 2048 + k * 1024); } while (0)
#define PG8_MMA(ai, bj, At, Bt) do { __builtin_amdgcn_s_setprio(1); _Pragma("unroll") for (int m = 0; m < 4; ++m) _Pragma("unroll") for (int n = 0; n < 2; ++n) _Pragma("unroll") for (int k = 0; k < 2; ++k) \
        acc[ai][bj][m][n] = __builtin_amdgcn_mfma_f32_16x16x32_bf16(Bt[n][k], At[m][k], acc[ai][bj][m][n], 0, 0, 0); __builtin_amdgcn_s_setprio(0); } while (0)
#define PG8_WAIT_V(n) asm volatile("s_waitcnt vmcnt(" #n ")" ::: "memory")
#define PG8_WAIT_L(n) asm volatile("s_waitcnt lgkmcnt(" #n ")" ::: "memory")
#define PG8_BAR __builtin_amdgcn_s_barrier()
#define PG8_SCHED __builtin_amdgcn_sched_barrier(0)
#define PG8_APTR(u) (g.A + (size_t)(u).pm * tstepA)
#define PG8_BPTR(u) (g.B + (size_t)((u).pb >> 3) * g.b_bs_hi + (size_t)((u).pb & 7) * g.b_bs_lo + (size_t)(u).pn * tstepB)
    Unit cur, nxt; int ui = 0;
    if (!gemm_next(g, 0, cur)) return;
    f32x4 acc[2][2][4][2];
#pragma unroll
    for (int a = 0; a < 2; ++a)
#pragma unroll
        for (int b = 0; b < 2; ++b)
#pragma unroll
            for (int m = 0; m < 4; ++m)
#pragma unroll
                for (int n = 0; n < 2; ++n) acc[a][b][m][n] = (f32x4){0.f, 0.f, 0.f, 0.f};
    bf16x8 At[4][2], B0[2][2], B1[2][2];
    const char* cA = PG8_APTR(cur); const char* cB = PG8_BPTR(cur);
    PG8_STAGE(PG8_SB(0, 0), cB, voffB); PG8_STAGE(PG8_SB(0, 1), cB + hstepB, voffB); PG8_STAGE(PG8_SA(0, 0), cA, voffA); PG8_STAGE(PG8_SA(0, 1), cA + hstepA, voffA);
    if (wr == 1) PG8_BAR;
    PG8_WAIT_V(2); PG8_BAR;
    PG8_STAGE(PG8_SB(1, 0), cB + kstep, voffB); PG8_STAGE(PG8_SA(1, 0), cA + kstep, voffA); PG8_STAGE(PG8_SB(1, 1), cB + hstepB + kstep, voffB);
    PG8_WAIT_V(6); PG8_BAR;
    for (;;) {
        const bool has_next = gemm_next(g, ui + 1, nxt);
        const char* nA = has_next ? PG8_APTR(nxt) : cA; const char* nB = has_next ? PG8_BPTR(nxt) : cB;
        for (int t = 0; t < nt; t += 2) {
            const bool last = (t == nt - 2);
            const char* a1 = cA + (size_t)(t + 1) * kstep;
            const char* a2 = last ? nA : cA + (size_t)(t + 2) * kstep; const char* b2 = last ? nB : cB + (size_t)(t + 2) * kstep;
            const char* a3 = a2 + kstep; const char* b3 = b2 + kstep;
            PG8_LDB(B0, 0, 0); PG8_LDB(B1, 0, 1); PG8_SCHED; PG8_LDA(At, 0, 0); PG8_STAGE(PG8_SA(1, 1), a1 + hstepA, voffA);
            PG8_WAIT_V(8); PG8_WAIT_L(0); PG8_BAR; PG8_MMA(0, 0, At, B0); PG8_MMA(0, 1, At, B1); PG8_BAR; PG8_SCHED;
            PG8_LDA(At, 0, 1); PG8_STAGE(PG8_SB(0, 0), b2, voffB); PG8_STAGE(PG8_SB(0, 1), b2 + hstepB, voffB); PG8_STAGE(PG8_SA(0, 0), a2, voffA);
            PG8_WAIT_V(8); PG8_WAIT_L(0); PG8_BAR; PG8_MMA(1, 0, At, B0); PG8_MMA(1, 1, At, B1); PG8_BAR; PG8_SCHED;
            PG8_LDB(B0, 1, 0); PG8_LDB(B1, 1, 1); PG8_SCHED; PG8_LDA(At, 1, 0); PG8_STAGE(PG8_SA(0, 1), a2 + hstepA, voffA);
            PG8_WAIT_V(8); PG8_WAIT_L(0); PG8_BAR; PG8_MMA(0, 0, At, B0); PG8_MMA(0, 1, At, B1); PG8_BAR; PG8_SCHED;
            PG8_LDA(At, 1, 1); PG8_STAGE(PG8_SB(1, 0), b3, voffB); PG8_STAGE(PG8_SB(1, 1), b3 + hstepB, voffB); PG8_STAGE(PG8_SA(1, 0), a3, voffA);
            PG8_WAIT_V(8); PG8_WAIT_L(0); PG8_BAR; PG8_MMA(1, 0, At, B0); PG8_MMA(1, 1, At, B1); PG8_BAR; PG8_SCHED;
        }
        if (wr == 0) PG8_BAR;
        gemm_epi(g, acc, cur, wr, wc, fr, fq);
        if (!has_next) break;
#pragma unroll
        for (int a = 0; a < 2; ++a)
#pragma unroll
            for (int b = 0; b < 2; ++b)
#pragma unroll
                for (int m = 0; m < 4; ++m)
#pragma unroll
                    for (int n = 0; n < 2; ++n) acc[a][b][m][n] = (f32x4){0.f, 0.f, 0.f, 0.f};
        cur = nxt; cA = nA; cB = nB; ++ui;
        if (wr == 1) PG8_BAR;
    }
    PG8_WAIT_V(0);
    PG8_BAR;
#undef PG8_SA
#undef PG8_SB
#undef PG8_STAGE
#undef PG8_LDA
#undef PG8_LDB
#undef PG8_MMA
#undef PG8_WAIT_V
#undef PG8_WAIT_L
#undef PG8_BAR
#undef PG8_SCHED
#undef PG8_APTR
#undef PG8_BPTR
}

__device__ __forceinline__ GemmP gemm_std(const void* A, int lda, const void* B, int ldb, int K, int nM, int nN) {
    GemmP g; g.A = (const char*)A; g.B = (const char*)B; g.lda = lda; g.ldb = ldb; g.K = K; g.nM = nM; g.nN = nN; g.nB = 1; g.extra = 0; g.b_bs_hi = 0; g.b_bs_lo = 0;
    g.mode = 0; g.act = 0; g.scale = 1.f; g.out = nullptr; g.ldc = 0; g.o_bs_hi = 0; g.o_bs_lo = 0; g.o_pm = 0; g.base = nullptr; g.gate = nullptr; g.bias = nullptr; g.base16 = 0; g.out16 = 0; return g;
}


#define XB_TMO      128
#define XB_XCNT(j)  (256  + 64 * (j))
#define XB_XSUB(j)  (1280 + 64 * (j))
#define XB_XGEN(j)  (2304 + 64 * (j))
#define XB_TOP      3328
#define XB_TOPGEN   3392
#define XCD_BAR_WORDS 3456
#define XB_SPIN_CAP (1u << 18)
__device__ __forceinline__ unsigned xb_ld(unsigned* p)              { return __hip_atomic_load(p, __ATOMIC_RELAXED, __HIP_MEMORY_SCOPE_AGENT); }
__device__ __forceinline__ unsigned xb_add(unsigned* p, unsigned v) { return __hip_atomic_fetch_add(p, v, __ATOMIC_RELAXED, __HIP_MEMORY_SCOPE_AGENT); }
__device__ __forceinline__ unsigned xb_xcc_id() { return (unsigned)__builtin_amdgcn_s_getreg((3 << 11) | 20) & 0xFu; }
#define XB_SPIN(cond, bar) do { unsigned _sp = 0; while (cond) { __builtin_amdgcn_s_sleep(1); \
    if ((++_sp & 255u) == 0u) { if (xb_ld(&(bar)[XB_TMO])) break; if (_sp > XB_SPIN_CAP) { atomicAdd(&(bar)[XB_TMO], 1u); break; } } } } while (0)
struct XcdBarrier { unsigned* bar; unsigned x; volatile LAS unsigned* st; };
__device__ __forceinline__ XcdBarrier xcd_barrier_post(unsigned* bar, volatile LAS unsigned* st) {
    XcdBarrier b; b.bar = bar; b.x = xb_xcc_id(); b.st = st;
    if (threadIdx.x == 0) (void)xb_add(&bar[XB_XCNT(b.x)], 1u);
    return b;
}
__device__ __forceinline__ void xcd_barrier_complete(unsigned* bar, unsigned x, unsigned& nloc, unsigned& nx) {
    const unsigned G = gridDim.x * gridDim.y * gridDim.z;
    unsigned sum, cnt, mine, sp = 0u;
    for (;;) {
        sum = 0u; cnt = 0u; mine = 0u;
#pragma unroll
        for (unsigned j = 0; j < 16; ++j) { const unsigned c = xb_ld(&bar[XB_XCNT(j)]); sum += c; cnt += (c > 0u) ? 1u : 0u; mine = (j == x) ? c : mine; }
        if (sum == G) break;
        __builtin_amdgcn_s_sleep(1);
        if ((++sp & 255u) == 0u) { if (xb_ld(&bar[XB_TMO])) break; if (sp > XB_SPIN_CAP) { atomicAdd(&bar[XB_TMO], 1u); break; } }
    }
    nloc = mine > 0u ? mine : 1u; nx = cnt > 0u ? cnt : 1u;
}
__device__ __forceinline__ void xcd_barrier(const XcdBarrier& b) {
    asm volatile("s_waitcnt vmcnt(0) lgkmcnt(0)" ::: "memory");
    __syncthreads();
    if (threadIdx.x == 0) {
        unsigned* bar = b.bar;
        __builtin_amdgcn_s_waitcnt(0);
        unsigned nloc = b.st[0], nx = b.st[1];
        if (nloc == 0u) { xcd_barrier_complete(bar, b.x, nloc, nx); b.st[0] = nloc; b.st[1] = nx; }
        const unsigned old = xb_add(&bar[XB_XSUB(b.x)], 1u);
        const unsigned gen = old / nloc;
        if (old + 1u == (gen + 1u) * nloc) {
            __builtin_amdgcn_fence(__ATOMIC_RELEASE, "agent");
            asm volatile("s_waitcnt vmcnt(0)" ::: "memory");
            const unsigned og = xb_add(&bar[XB_TOP], 1u);
            const unsigned tg = og / nx;
            if (og + 1u == (tg + 1u) * nx) xb_add(&bar[XB_TOPGEN], 1u);
            else XB_SPIN(xb_ld(&bar[XB_TOPGEN]) == tg, bar);
            __builtin_amdgcn_fence(__ATOMIC_ACQUIRE, "agent");
            xb_add(&bar[XB_XGEN(b.x)], 1u);
            asm volatile("s_waitcnt vmcnt(0)" ::: "memory");
        } else {
            XB_SPIN(xb_ld(&bar[XB_XGEN(b.x)]) == gen, bar);
            __builtin_amdgcn_fence(__ATOMIC_ACQUIRE, "agent");
            asm volatile("s_waitcnt vmcnt(0)" ::: "memory");
        }
    }
    __syncthreads();
}

__device__ __forceinline__ void ada_phase(const Params& P, LAS unsigned char* lds) {
    const int tid = threadIdx.x;
    LAS f32x4* sA = (LAS f32x4*)lds;
    LAS f32x4* sB = sA + 2048;
    LAS float* sC = (LAS float*)(sB + 2048);
    LAS float* part = sC + 2048;
    const float* c = P.in[1]; const float* cc = P.in[3];
    for (int i = tid; i < 2048; i += 512) {
        sA[i] = (f32x4){silu_f(c[0 * 2048 + i]), silu_f(c[1 * 2048 + i]), silu_f(c[2 * 2048 + i]), silu_f(c[3 * 2048 + i])};
        sB[i] = (f32x4){silu_f(c[4 * 2048 + i]), silu_f(c[5 * 2048 + i]), silu_f(c[6 * 2048 + i]), silu_f(c[7 * 2048 + i])};
        sC[i] = silu_f(cc[i]); }
    __syncthreads();
    float* mod = (float*)(P.ws + WS_MOD);
    for (int cb = blockIdx.x; cb < 256; cb += gridDim.x) {
        const int colbase = cb * 96, l = colbase / 12288, cl = colbase % 12288;
        const float* W = P.in[4] + (size_t)l * 2048 * 12288 + cl;
        const int c4 = tid % 24, kp = tid / 24;
        if (tid < 384) {
            f32x4 acc[9];
#pragma unroll
            for (int r = 0; r < 9; ++r) acc[r] = (f32x4){0.f, 0.f, 0.f, 0.f};
            const float* wp = W + (size_t)(kp * 128) * 12288 + c4 * 4;
            for (int i0 = 0; i0 < 128; i0 += 16) {
                f32x4 wv[16];
#pragma unroll
                for (int u = 0; u < 16; ++u) wv[u] = __builtin_nontemporal_load((const f32x4*)(wp + (size_t)(i0 + u) * 12288));
#pragma unroll
                for (int u = 0; u < 16; ++u) { const int i = i0 + u; const f32x4 w = wv[u];
                    const f32x4 s0 = sA[kp * 128 + i], s1 = sB[kp * 128 + i]; const float s2 = sC[kp * 128 + i];
                    acc[0] += w * s0[0]; acc[1] += w * s0[1]; acc[2] += w * s0[2]; acc[3] += w * s0[3];
                    acc[4] += w * s1[0]; acc[5] += w * s1[1]; acc[6] += w * s1[2]; acc[7] += w * s1[3];
                    acc[8] += w * s2; }
            }
#pragma unroll
            for (int r = 0; r < 9; ++r) *(LAS f32x4*)(part + kp * 864 + r * 96 + c4 * 4) = acc[r];
        }
        __syncthreads();
        for (int o = tid; o < 864; o += 512) {
            float s = 0.f;
#pragma unroll
            for (int k = 0; k < 16; ++k) s += part[k * 864 + o];
            const int r = o / 96, col = o % 96;
            mod[(size_t)(l * 9 + r) * 12288 + cl + col] = s + P.in[5][l * 12288 + cl + col];
        }
        __syncthreads();
    }
}

__device__ __forceinline__ void transpose_item(const float* W, int K, int N, bf16_t* WT, LAS float* scr, int item, int lane) {
    const int nblk = N / 32, kb = item / nblk, nb = item % nblk, k0 = 64 * kb, n0 = 32 * nb;
    float v[32];
    const float* wp = W + (size_t)(k0 + (lane >> 5)) * N + n0 + (lane & 31);
#pragma unroll
    for (int i = 0; i < 32; ++i) v[i] = __builtin_nontemporal_load(wp + (size_t)(2 * i) * N);
#pragma unroll
    for (int i = 0; i < 32; ++i) scr[(2 * i + (lane >> 5)) * 33 + (lane & 31)] = v[i];
    asm volatile("s_waitcnt lgkmcnt(0)" ::: "memory");
    const int c = lane & 7;
#pragma unroll
    for (int j = 0; j < 4; ++j) { const int n = (lane >> 3) + 8 * j; const LAS float* s = scr + (8 * c) * 33 + n;
        u32x4 o; o.x = cvt_pk_bf16(s[0 * 33], s[1 * 33]); o.y = cvt_pk_bf16(s[2 * 33], s[3 * 33]); o.z = cvt_pk_bf16(s[4 * 33], s[5 * 33]); o.w = cvt_pk_bf16(s[6 * 33], s[7 * 33]);
        *(u32x4*)(WT + (size_t)(n0 + n) * K + k0 + 8 * c) = o; }
    asm volatile("s_waitcnt lgkmcnt(0)" ::: "memory");
}

__device__ __forceinline__ void weights_phase(const Params& P, LAS unsigned char* lds) {
    const int tid = threadIdx.x, lane = tid & 63, wave = __builtin_amdgcn_readfirstlane(tid >> 6);
    LAS float* scr = (LAS float*)(lds + wave * 8704);
    const int gw = blockIdx.x * 8 + wave, NGW = gridDim.x * 8;
    constexpr int I_IN = (D / 64) * (INC / 32), I_SQ = (D / 64) * (D / 32), I_1 = (D / 64) * (DFF / 32), I_2 = (DFF / 64) * (D / 32);
    constexpr int NIT = I_IN + 2 * I_SQ + 2 * I_1 + 2 * I_2;
    bf16_t* ws16;
    for (int it = gw; it < NIT; it += NGW) {
        int r = it;
        if (r < I_IN) { ws16 = (bf16_t*)(P.ws + WS_WIN); transpose_item(P.in[10], D, INC, ws16, scr, r, lane); continue; } r -= I_IN;
        if (r < I_SQ) { ws16 = (bf16_t*)(P.ws + WS_WOUT); transpose_item(P.in[19], D, D, ws16, scr, r, lane); continue; } r -= I_SQ;
        if (r < I_SQ) { ws16 = (bf16_t*)(P.ws + WS_CW); transpose_item(P.in[20], D, D, ws16, scr, r, lane); continue; } r -= I_SQ;
        if (r < 2 * I_1) { const int l = r / I_1; ws16 = (bf16_t*)(P.ws + WS_W1) + (size_t)l * DFF * D; transpose_item(P.in[8] + (size_t)l * D * DFF, D, DFF, ws16, scr, r % I_1, lane); continue; } r -= 2 * I_1;
        { const int l = r / I_2; ws16 = (bf16_t*)(P.ws + WS_W2) + (size_t)l * D * DFF; transpose_item(P.in[9] + (size_t)l * DFF * D, DFF, D, ws16, scr, r % I_2, lane); }
    }
    const int gt = blockIdx.x * 512 + tid, NGT = gridDim.x * 512;
    bf16_t* CN = (bf16_t*)(P.ws + WS_CN);
    for (int idx = gt; idx < 2048 * 256; idx += NGT) { const int k = idx >> 8, j0 = (idx & 255) * 8; float v[8];
#pragma unroll
        for (int e = 0; e < 8; ++e) { const int j = j0 + e; const int t = j & 1023; const float a = (float)((k * t) & 2047) * (1.f / 1024.f);
            v[e] = (j < 1024) ? cospif(a) : (t == 0 ? ((k & 1) ? -1.f : 1.f) : -sinpif(a)); }
        u32x4 o; o.x = cvt_pk_bf16(v[0], v[1]); o.y = cvt_pk_bf16(v[2], v[3]); o.z = cvt_pk_bf16(v[4], v[5]); o.w = cvt_pk_bf16(v[6], v[7]);
        *(u32x4*)(CN + (size_t)k * 2048 + j0) = o; }
    bf16_t* CMA = (bf16_t*)(P.ws + WS_CMA);
    for (int idx = gt; idx < 512 * 32; idx += NGT) { const int r = idx >> 5, c0 = (idx & 31) * 8; float v[8];
#pragma unroll
        for (int e = 0; e < 8; ++e) { const int cix = c0 + e; const float a = (float)(((r & 255) * cix) & 255) * (1.f / 128.f); v[e] = (r < 256) ? cospif(a) : sinpif(a); }
        u32x4 o; o.x = cvt_pk_bf16(v[0], v[1]); o.y = cvt_pk_bf16(v[2], v[3]); o.z = cvt_pk_bf16(v[4], v[5]); o.w = cvt_pk_bf16(v[6], v[7]);
        *(u32x4*)(CMA + (size_t)r * 256 + c0) = o; }
}

__device__ __forceinline__ f32x4 ld4_bf16(const bf16_t* p) { const u32x2 w = *(const u32x2*)p; return (f32x4){__uint_as_float(w.x << 16), __uint_as_float(w.x & 0xffff0000u), __uint_as_float(w.y << 16), __uint_as_float(w.y & 0xffff0000u)}; }
__device__ __forceinline__ void norm_phase(const float* src_lat, const float* src_ctx, int nrows, const float* gain, const float* mod_l, int sh_chunk, int sc_chunk, bf16_t* dst, const bf16_t* lr_t = nullptr, bf16_t* lr_out = nullptr, const bf16_t* src16 = nullptr, LAS unsigned char* lds = nullptr) {
    const int tid = threadIdx.x, lane = tid & 63, wave = tid >> 6;
    if (lr_t != nullptr) {
        const u32x4* s4 = (const u32x4*)(lr_t + (size_t)C_LRF * D);
        for (int i = tid; i < 32 * D * 2 / 16; i += 512) ((LAS u32x4*)lds)[i] = s4[i];
        __syncthreads();
    }
    const int gw = blockIdx.x * 8 + wave, nw = gridDim.x * 8, per = (NTOK + nw - 1) / nw; const bool contig = (per * nw == NTOK);
    const int nctx_it = nrows > NTOK ? (nrows - NTOK + nw - 1) / nw : 0;
    f32x4 gam[8], shv[8]; int curb = -1;
    for (int it = 0; it < per + nctx_it; ++it) {
        const int row = it < per ? (contig ? gw * per + it : gw + it * nw) : NTOK + gw + (it - per) * nw;
        if (row >= nrows || (it < per && row >= NTOK)) continue;
        const float* xr = row < NTOK ? src_lat + (size_t)row * D : src_ctx + (size_t)(row - NTOK) * D;
        const int mr = row < NTOK ? (row >> 11) : 8;
        if (mr != curb) { curb = mr; const float* sh = mod_l + (size_t)mr * 12288 + sh_chunk * 2048; const float* sc = mod_l + (size_t)mr * 12288 + sc_chunk * 2048;
#pragma unroll
            for (int j = 0; j < 8; ++j) { const int c0 = (lane + 64 * j) * 4; gam[j] = *(const f32x4*)(gain + c0) * (*(const f32x4*)(sc + c0) + 1.f); shv[j] = *(const f32x4*)(sh + c0); } }
        f32x4 v[8]; float ss = 0.f;
#pragma unroll
        for (int j = 0; j < 8; ++j) { v[j] = src16 ? ld4_bf16(src16 + (size_t)row * D + (lane + 64 * j) * 4) : *(const f32x4*)(xr + (lane + 64 * j) * 4); ss += (v[j][0] * v[j][0] + v[j][1] * v[j][1]) + (v[j][2] * v[j][2] + v[j][3] * v[j][3]); }
        const float rstd = rsqrtf(wave_sum(ss) * (1.f / D) + 1e-6f);
#pragma unroll
        for (int j = 0; j < 8; ++j) { const int c0 = (lane + 64 * j) * 4;
            const f32x4 y = v[j] * rstd * gam[j] + shv[j];
            u32x2 w; w.x = cvt_pk_bf16(y[0], y[1]); w.y = cvt_pk_bf16(y[2], y[3]);
            *(u32x2*)(dst + (size_t)row * D + c0) = w; v[j] = y; }
        if (lr_t != nullptr && row >= NTOK) {
            float mine = 0.f;
#pragma unroll 4
            for (int c = 0; c < 32; ++c) { const LAS unsigned char* wr = lds + c * 4096 + lane * 8; float a = 0.f;
#pragma unroll
                for (int j = 0; j < 8; ++j) { const u32x2 w = *(const LAS u32x2*)(wr + j * 512);
                    a += (v[j][0] * __uint_as_float(w.x << 16) + v[j][1] * __uint_as_float(w.x & 0xffff0000u)) + (v[j][2] * __uint_as_float(w.y << 16) + v[j][3] * __uint_as_float(w.y & 0xffff0000u)); }
                const float s = wave_sum(a); mine = (lane == c) ? s : mine; }
            if (lane < 32) lr_out[(size_t)row * INCP + C_LRF + lane] = f2bf1(mine);
        }
    }
}


__device__ __forceinline__ void norm_pair_phase(const bf16_t* src, const float* gain, const float* mod_l, bf16_t* dst) {
    const int tid = threadIdx.x, lane = tid & 63, wave = tid >> 6;
    const int gw = blockIdx.x * 8 + wave, nw = gridDim.x * 8;
    const int wpb = nw / NBATCH; const bool ok = (wpb * NBATCH == nw) && wpb > 0 && (1024 % (wpb > 0 ? wpb : 1) == 0);
    const int per = ok ? 1024 / wpb + 1 : 0;
    const int b0 = ok ? gw / wpb : 0, wb = ok ? gw - b0 * wpb : 0;
    f32x4 gam[8], shv[8]; int curb = -1;
    const int total = ok ? per : (NBATCH * 1025 + nw - 1) / nw;
    for (int it = 0; it < total; ++it) {
        int b, j;
        if (ok) { b = b0; if (it < per - 1) j = wb * (per - 1) + it; else { if (wb != wpb - 1) continue; j = 1024; } if (j > 1024) continue; }
        else { const int idx = gw + it * nw; if (idx >= NBATCH * 1025) continue; b = idx / 1025; j = idx - b * 1025; }
        if (b != curb) { curb = b; const float* sh = mod_l + (size_t)b * 12288 + 0 * 2048; const float* sc = mod_l + (size_t)b * 12288 + 1 * 2048;
#pragma unroll
            for (int q = 0; q < 8; ++q) { const int c0 = (lane + 64 * q) * 4; gam[q] = *(const f32x4*)(gain + c0) * (*(const f32x4*)(sc + c0) + 1.f); shv[q] = *(const f32x4*)(sh + c0); } }
        const bool pair = (j >= 1 && j <= 1023);
        const bf16_t* x1 = src + (size_t)(b * SEQ + j) * D; const bf16_t* x2 = src + (size_t)(b * SEQ + (pair ? SEQ - j : j)) * D;
        f32x4 v1[8], v2[8]; float s1 = 0.f, s2 = 0.f;
#pragma unroll
        for (int q = 0; q < 8; ++q) { v1[q] = ld4_bf16(x1 + (lane + 64 * q) * 4); v2[q] = ld4_bf16(x2 + (lane + 64 * q) * 4);
            s1 += (v1[q][0] * v1[q][0] + v1[q][1] * v1[q][1]) + (v1[q][2] * v1[q][2] + v1[q][3] * v1[q][3]);
            s2 += (v2[q][0] * v2[q][0] + v2[q][1] * v2[q][1]) + (v2[q][2] * v2[q][2] + v2[q][3] * v2[q][3]); }
        const float r1 = rsqrtf(wave_sum(s1) * (1.f / D) + 1e-6f), r2 = rsqrtf(wave_sum(s2) * (1.f / D) + 1e-6f);
        bf16_t* de = dst + (size_t)(b * SEQ + (j == 1024 ? 1024 : j)) * D; bf16_t* dq = dst + (size_t)(b * SEQ + 1024 + j) * D;
#pragma unroll
        for (int q = 0; q < 8; ++q) { const int c0 = (lane + 64 * q) * 4;
            const f32x4 y1 = v1[q] * r1 * gam[q] + shv[q], y2 = v2[q] * r2 * gam[q] + shv[q];
            const f32x4 e4 = pair ? y1 + y2 : y1, o4 = y1 - y2;
            u32x2 w; w.x = cvt_pk_bf16(e4[0], e4[1]); w.y = cvt_pk_bf16(e4[2], e4[3]);
            *(u32x2*)(de + c0) = w;
            if (pair) { u32x2 w2; w2.x = cvt_pk_bf16(o4[0], o4[1]); w2.y = cvt_pk_bf16(o4[2], o4[3]); *(u32x2*)(dq + c0) = w2; } }
    }
}

__device__ __forceinline__ float log_sigmoid_f(float z) { return fminf(z, 0.f) - __logf(1.f + __expf(-fabsf(z))); }

constexpr float QSCALE = 0.08838834764831845f, LOG2E = 1.4426950408889634f;

__device__ __forceinline__ void prep_phase(const Params& P, LAS unsigned char* lds) {
    const int tid = threadIdx.x;
    const bf16_t* proj = (const bf16_t*)(P.ws + WS_PROJ);
    bf16_t* Qp = (bf16_t*)(P.ws + WS_QP); bf16_t* Kp = (bf16_t*)(P.ws + WS_KP);
    {
        const int i = tid & 31; const float invf = powf(10000.f, -(float)i / 32.f);
        const int NHR = NTOK * 10 + NCTX * 2;
        const float gq0 = P.in[11][i], gq1 = P.in[11][32 + i], gq2 = P.in[11][64 + i], gq3 = P.in[11][96 + i];
        const float gk0 = P.in[12][i], gk1 = P.in[12][32 + i], gk2 = P.in[12][64 + i], gk3 = P.in[12][96 + i];
        const int hw = blockIdx.x * 16 + (tid >> 5), nhw = gridDim.x * 16;
        for (int base = 0; base < NHR; base += 4 * nhw) {
            float xv[4][4]; int rows[4], hhs[4];
#pragma unroll
            for (int u = 0; u < 4; ++u) {
                int idx = base + u * nhw + hw; if (idx >= NHR) idx = NHR - 1;
                int row, hh; if (idx < NTOK * 10) { row = idx / 10; hh = idx - row * 10; } else { const int j = idx - NTOK * 10; row = NTOK + (j >> 1); hh = 8 + (j & 1); }
                rows[u] = row; hhs[u] = hh;
                const int col0 = hh < 8 ? hh * 128 : C_AK + (hh - 8) * 128;
                const bf16_t* pr = proj + (size_t)row * INCP + col0 + i;
                xv[u][0] = bf2f(pr[0]); xv[u][1] = bf2f(pr[32]); xv[u][2] = bf2f(pr[64]); xv[u][3] = bf2f(pr[96]);
            }
#pragma unroll
            for (int u = 0; u < 4; ++u) {
                const int row = rows[u], hh = hhs[u];
                float x0 = xv[u][0], x1 = xv[u][1], x2 = xv[u][2], x3 = xv[u][3];
                float ss = x0 * x0 + x1 * x1 + x2 * x2 + x3 * x3;
#pragma unroll
                for (int o = 1; o < 32; o <<= 1) ss += __shfl_xor(ss, o);
                const float rstd = rsqrtf(ss * (1.f / 128.f) + 1e-6f);
                if (hh < 8) { x0 *= rstd * gq0; x1 *= rstd * gq1; x2 *= rstd * gq2; x3 *= rstd * gq3; }
                else { x0 *= rstd * gk0; x1 *= rstd * gk1; x2 *= rstd * gk2; x3 *= rstd * gk3; }
                if (row < NTOK) {
                    const int t = row & 2047, rr = t >> 6, cc = t & 63;
                    float sr, cr, sc_, cc_; sincosf((float)rr * invf, &sr, &cr); sincosf((float)cc * invf, &sc_, &cc_);
                    const float y0 = x0 * cr - x1 * sr, y1 = x1 * cr + x0 * sr, y2 = x2 * cc_ - x3 * sc_, y3 = x3 * cc_ + x2 * sc_;
                    x0 = y0; x1 = y1; x2 = y2; x3 = y3;
                }
                bf16_t* op;
                if (hh < 8) { const int b = row >> 11, t = row & 2047; const float qs = QSCALE * LOG2E; x0 *= qs; x1 *= qs; x2 *= qs; x3 *= qs;
                    op = Qp + ((size_t)(b * 8 + hh) * SEQ + t) * 128 + i; }
                else { int b, pos; if (row < NTOK) { b = row >> 11; pos = CTXL + (row & 2047); } else { b = (row - NTOK) >> 8; pos = (row - NTOK) & 255; }
                    op = Kp + ((size_t)(b * 2 + (hh - 8)) * KVLEN + pos) * 128 + i; }
                if (base + u * nhw + hw < NHR) { op[0] = f2bf1(x0); op[32] = f2bf1(x1); op[64] = f2bf1(x2); op[96] = f2bf1(x3); }
            }
        }
    }
    {
        bf16_t* QE = (bf16_t*)(P.ws + WS_QE); bf16_t* KE = (bf16_t*)(P.ws + WS_KE); bf16_t* KDT = (bf16_t*)(P.ws + WS_KDT);
        float* DEC = (float*)(P.ws + WS_DEC); bf16_t* VT = (bf16_t*)(P.ws + WS_VT); bf16_t* VTA = (bf16_t*)(P.ws + WS_VTA);
        LAS float* tot = (LAS float*)lds;
        LAS bf16_t* vt = (LAS bf16_t*)(lds + 4096);
        const int d = tid & 127, part = tid >> 7;
        for (int item = blockIdx.x; item < NBATCH * 4 * 36; item += gridDim.x) {
            const int pc = item % 36, h = (item / 36) & 3, b = item / 144;
            const int row0 = pc < 4 ? NTOK + b * CTXL + pc * 64 : b * SEQ + (pc - 4) * 64;
            float g0[16], g1[16];
            {
                float gkf[16], gkb[16];
#pragma unroll
                for (int r = 0; r < 16; ++r) { gkf[r] = P.in[14][r * 512 + h * 128 + d]; gkb[r] = P.in[16][r * 512 + h * 128 + d]; }
                const float bf_ = P.in[15][h * 128 + d], bb_ = P.in[17][h * 128 + d];
#pragma unroll
                for (int i = 0; i < 16; ++i) {
                    const bf16_t* lr = proj + (size_t)(row0 + part * 16 + i) * INCP + C_LRF;
                    const u32x4 w0 = *(const u32x4*)lr, w1 = *(const u32x4*)(lr + 8), w2 = *(const u32x4*)(lr + 16), w3 = *(const u32x4*)(lr + 24);
                    float zf = bf_, zb = bb_;
#pragma unroll
                    for (int e = 0; e < 4; ++e) {
                        zf += __uint_as_float(w0[e] << 16) * gkf[2 * e] + __uint_as_float(w0[e] & 0xffff0000u) * gkf[2 * e + 1];
                        zf += __uint_as_float(w1[e] << 16) * gkf[8 + 2 * e] + __uint_as_float(w1[e] & 0xffff0000u) * gkf[8 + 2 * e + 1];
                        zb += __uint_as_float(w2[e] << 16) * gkb[2 * e] + __uint_as_float(w2[e] & 0xffff0000u) * gkb[2 * e + 1];
                        zb += __uint_as_float(w3[e] << 16) * gkb[8 + 2 * e] + __uint_as_float(w3[e] & 0xffff0000u) * gkb[8 + 2 * e + 1];
                    }
                    g0[i] = log_sigmoid_f(zf) * (1.f / 16.f); g1[i] = log_sigmoid_f(zb) * (1.f / 16.f);
                }
            }
            float run0 = 0.f, run1 = 0.f;
#pragma unroll
            for (int i = 0; i < 16; ++i) { run0 += g0[i]; g0[i] = run0; }
#pragma unroll
            for (int i = 15; i >= 0; --i) { run1 += g1[i]; g1[i] = run1; }
            tot[(0 * 4 + part) * 128 + d] = run0; tot[(1 * 4 + part) * 128 + d] = run1;
#pragma unroll
            for (int j = 0; j < 4; ++j) { const int chunk = tid + 512 * j, rr = chunk >> 5, sg = chunk & 31;
                *(LAS u32x4*)(vt + rr * 264 + sg * 8) = *(const u32x4*)(proj + (size_t)(row0 + rr) * INCP + C_BV + h * 256 + sg * 8); }
            __syncthreads();
            float off0 = 0.f, off1 = 0.f, bt0 = 0.f, bt1 = 0.f;
#pragma unroll
            for (int p = 0; p < 4; ++p) { const float t0 = tot[p * 128 + d], t1 = tot[(4 + p) * 128 + d]; bt0 += t0; bt1 += t1; if (p < part) off0 += t0; if (p > part) off1 += t1; }
            const int ch0 = (0 * 8 + b) * 4 + h, ch1 = (1 * 8 + b) * 4 + h;
            unsigned kd0[8], kd1[8];
            bf16_t qraw[16], kraw[16];
#pragma unroll
            for (int i = 0; i < 16; ++i) { const bf16_t* pr = proj + (size_t)(row0 + part * 16 + i) * INCP + h * 128 + d; qraw[i] = pr[C_BQ]; kraw[i] = pr[C_BK]; }
#pragma unroll
            for (int i2 = 0; i2 < 8; ++i2) {
                float kdv0[2], kdv1[2];
#pragma unroll
                for (int u = 0; u < 2; ++u) {
                    const int i = 2 * i2 + u, c = part * 16 + i, pos = pc * 64 + c;
                    const float q = bf2f(qraw[i]) * QSCALE, k = bf2f(kraw[i]);
                    const float b0 = off0 + g0[i], b1 = off1 + g1[i];
                    const size_t o0 = ((size_t)ch0 * KVLEN + pos) * 128 + d, o1 = ((size_t)ch1 * KVLEN + pos) * 128 + d;
                    if (pc >= 4) { QE[o0] = f2bf1(q * __expf(b0)); QE[o1] = f2bf1(q * __expf(b1)); }
                    KE[o0] = f2bf1(k * __expf(-b0)); KE[o1] = f2bf1(k * __expf(-b1));
                    kdv0[u] = k * __expf(bt0 - b0); kdv1[u] = k * __expf(bt1 - b1);
                }
                kd0[i2] = cvt_pk_bf16(kdv0[0], kdv0[1]); kd1[i2] = cvt_pk_bf16(kdv1[0], kdv1[1]);
            }
            { u32x4* p0 = (u32x4*)(KDT + (((size_t)ch0 * 36 + pc) * 128 + d) * 64 + part * 16); p0[0] = (u32x4){kd0[0], kd0[1], kd0[2], kd0[3]}; p0[1] = (u32x4){kd0[4], kd0[5], kd0[6], kd0[7]};
              u32x4* p1 = (u32x4*)(KDT + (((size_t)ch1 * 36 + pc) * 128 + d) * 64 + part * 16); p1[0] = (u32x4){kd1[0], kd1[1], kd1[2], kd1[3]}; p1[1] = (u32x4){kd1[4], kd1[5], kd1[6], kd1[7]}; }
            if (part == 0) { DEC[((size_t)ch0 * 36 + pc) * 128 + d] = __expf(bt0); DEC[((size_t)ch1 * 36 + pc) * 128 + d] = __expf(bt1); }
            { const int e = tid & 255, half = tid >> 8; unsigned w[16];
#pragma unroll
              for (int i = 0; i < 16; ++i) w[i] = (unsigned)vt[(half * 32 + 2 * i) * 264 + e] | ((unsigned)vt[(half * 32 + 2 * i + 1) * 264 + e] << 16);
              u32x4* vp = (u32x4*)(VT + ((size_t)((b * 4 + h) * 256 + e)) * KVLEN + pc * 64 + half * 32);
              vp[0] = (u32x4){w[0], w[1], w[2], w[3]}; vp[1] = (u32x4){w[4], w[5], w[6], w[7]}; vp[2] = (u32x4){w[8], w[9], w[10], w[11]}; vp[3] = (u32x4){w[12], w[13], w[14], w[15]}; }
            __syncthreads();
            if (h < 2) {
#pragma unroll
                for (int j = 0; j < 2; ++j) { const int chunk = tid + 512 * j, rr = chunk >> 4, sg = chunk & 15;
                    *(LAS u32x4*)(vt + rr * 264 + sg * 8) = *(const u32x4*)(proj + (size_t)(row0 + rr) * INCP + C_AV + h * 128 + sg * 8); }
                __syncthreads();
                { const int dim = tid & 127, qt = tid >> 7; unsigned w[8];
#pragma unroll
                  for (int i = 0; i < 8; ++i) w[i] = (unsigned)vt[(qt * 16 + 2 * i) * 264 + dim] | ((unsigned)vt[(qt * 16 + 2 * i + 1) * 264 + dim] << 16);
                  u32x4* vp = (u32x4*)(VTA + ((size_t)((b * 2 + h) * 128 + dim)) * KVLEN + pc * 64 + qt * 16);
                  vp[0] = (u32x4){w[0], w[1], w[2], w[3]}; vp[1] = (u32x4){w[4], w[5], w[6], w[7]}; }
                __syncthreads();
            }
        }
    }
}

#define MFMA16(a, b, c) __builtin_amdgcn_mfma_f32_16x16x32_bf16((a), (b), (c), 0, 0, 0)
__device__ __forceinline__ void attn_item(const Params& P, int item, LAS unsigned char* lds, float mfix2) {
    const int tid = threadIdx.x, lane = tid & 63, wave = __builtin_amdgcn_readfirstlane(tid >> 6), r16 = lane & 15, q4 = lane >> 4;
    const int hp = item & 1, qb = (item >> 1) & 15, kvh = (item >> 5) & 1, b = item >> 6;
    const int head = kvh * 4 + hp * 2 + (wave >> 2), rw0 = (wave & 3) * 32, q0 = qb * 128;
    const bf16_t* Kb = (const bf16_t*)(P.ws + WS_KP) + (size_t)(b * 2 + kvh) * KVLEN * 128;
    const bf16_t* Vtb = (const bf16_t*)(P.ws + WS_VTA) + (size_t)(b * 2 + kvh) * 128 * KVLEN;
    bf16_t* mix = (bf16_t*)(P.ws + WS_MIX);
    LAS unsigned char* Pw = lds + 71680 + wave * 4608;
    bf16x8 qf[2][4];
    { const bf16_t* qbase = (const bf16_t*)(P.ws + WS_QP) + ((size_t)(b * 8 + head) * SEQ + q0 + rw0) * 128;
#pragma unroll
      for (int rb = 0; rb < 2; ++rb)
#pragma unroll
          for (int ks = 0; ks < 4; ++ks) qf[rb][ks] = *(const bf16x8*)(qbase + (rb * 16 + r16) * 128 + ks * 32 + q4 * 8); }
    const float psink = exp2f(P.in[13][head] * LOG2E - mfix2);
    f32x4 o[2][8]; float lsum[2][4];
#pragma unroll
    for (int rb = 0; rb < 2; ++rb) {
#pragma unroll
        for (int db = 0; db < 8; ++db) o[rb][db] = (f32x4){0.f, 0.f, 0.f, 0.f};
#pragma unroll
        for (int j = 0; j < 4; ++j) lsum[rb][j] = 0.f; }
    const int lt_first = qb == 0 ? 0 : (qb - 1) * 2, lt_last = (qb * 2 + 3) > 31 ? 31 : (qb * 2 + 3), ntiles = 4 + lt_last - lt_first + 1;
    const int kkey0 = tid >> 4, kseg = tid & 15, vdim0 = tid >> 3, vseg = tid & 7;
    u32x4 krA[2], vrA[2], krB[2], vrB[2];
#define ATT_POS0(i) ((i) < 4 ? (i) * 64 : CTXL + (lt_first + (i) - 4) * 64)
#define ATT_LOAD(i, kr, vr) do { const int _p = ATT_POS0(i); \
        kr[0] = *(const u32x4*)(Kb + (size_t)(_p + kkey0) * 128 + kseg * 8); kr[1] = *(const u32x4*)(Kb + (size_t)(_p + kkey0 + 32) * 128 + kseg * 8); \
        vr[0] = *(const u32x4*)(Vtb + (size_t)vdim0 * KVLEN + _p + vseg * 8); vr[1] = *(const u32x4*)(Vtb + (size_t)(vdim0 + 64) * KVLEN + _p + vseg * 8); } while (0)
#define ATT_STORE(bi, kr, vr) do { LAS unsigned char* _k = lds + (bi) * 17408; LAS unsigned char* _v = lds + 34816 + (bi) * 18432; \
        *(LAS u32x4*)(_k + kkey0 * 272 + kseg * 16) = kr[0]; *(LAS u32x4*)(_k + (kkey0 + 32) * 272 + kseg * 16) = kr[1]; \
        *(LAS u32x4*)(_v + vdim0 * 144 + vseg * 16) = vr[0]; *(LAS u32x4*)(_v + (vdim0 + 64) * 144 + vseg * 16) = vr[1]; } while (0)
    ATT_LOAD(0, krA, vrA); ATT_STORE(0, krA, vrA);
    ATT_LOAD(1, krA, vrA);
    __syncthreads();
    for (int i0 = 0; i0 < ntiles; i0 += 2) {
        { const int i = i0;
          if (i + 2 < ntiles) ATT_LOAD(i + 2, krB, vrB);
        const LAS unsigned char* kbuf = lds + (i & 1) * 17408; const LAS unsigned char* vbuf = lds + 34816 + (i & 1) * 18432;
        const int p0 = ATT_POS0(i); const int lt = lt_first + i - 4;
        const bool masked = (i >= 4) && (lt < qb * 2 || lt > qb * 2 + 1);
        const bool live = !masked || ((p0 - CTXL + 63 >= q0 + rw0 - 128) && (p0 - CTXL <= q0 + rw0 + 31 + 128));
        if (live) {
        f32x4 s[2][4];
#pragma unroll
        for (int rb = 0; rb < 2; ++rb)
#pragma unroll
            for (int cb = 0; cb < 4; ++cb) s[rb][cb] = (f32x4){0.f, 0.f, 0.f, 0.f};
#pragma unroll
        for (int ks = 0; ks < 4; ++ks)
#pragma unroll
            for (int cb = 0; cb < 4; ++cb) { const bf16x8 kf = *(const LAS bf16x8*)(kbuf + (cb * 16 + r16) * 272 + ks * 64 + q4 * 16);
#pragma unroll
                for (int rb = 0; rb < 2; ++rb) s[rb][cb] = MFMA16(qf[rb][ks], kf, s[rb][cb]); }
#pragma unroll
        for (int rb = 0; rb < 2; ++rb)
#pragma unroll
            for (int cb = 0; cb < 4; ++cb)
#pragma unroll
                for (int j = 0; j < 4; ++j) {
                    float p = exp2f(s[rb][cb][j] - mfix2);
                    if (masked) { const int dq = (q0 + rw0 + rb * 16 + q4 * 4 + j) - (p0 - CTXL + cb * 16 + r16); if (dq > 128 || dq < -128) p = 0.f; }
                    lsum[rb][j] += p;
                    *(LAS bf16_t*)(Pw + (rb * 16 + q4 * 4 + j) * 144 + (cb * 16 + r16) * 2) = f2bf1(p);
                }
        asm volatile("s_waitcnt lgkmcnt(0)" ::: "memory");
#pragma unroll
        for (int ks = 0; ks < 2; ++ks) { bf16x8 pf[2];
#pragma unroll
            for (int rb = 0; rb < 2; ++rb) pf[rb] = *(const LAS bf16x8*)(Pw + (rb * 16 + r16) * 144 + ks * 64 + q4 * 16);
#pragma unroll
            for (int db = 0; db < 8; ++db) { const bf16x8 vf = *(const LAS bf16x8*)(vbuf + (db * 16 + r16) * 144 + ks * 64 + q4 * 16);
#pragma unroll
                for (int rb = 0; rb < 2; ++rb) o[rb][db] = MFMA16(pf[rb], vf, o[rb][db]); } }
        }
        asm volatile("s_waitcnt lgkmcnt(0)" ::: "memory");

          ATT_STORE(1, krA, vrA);
          __syncthreads(); }
        { const int i = i0 + 1;
          if (i + 2 < ntiles) ATT_LOAD(i + 2, krA, vrA);
        const LAS unsigned char* kbuf = lds + (i & 1) * 17408; const LAS unsigned char* vbuf = lds + 34816 + (i & 1) * 18432;
        const int p0 = ATT_POS0(i); const int lt = lt_first + i - 4;
        const bool masked = (i >= 4) && (lt < qb * 2 || lt > qb * 2 + 1);
        const bool live = !masked || ((p0 - CTXL + 63 >= q0 + rw0 - 128) && (p0 - CTXL <= q0 + rw0 + 31 + 128));
        if (live) {
        f32x4 s[2][4];
#pragma unroll
        for (int rb = 0; rb < 2; ++rb)
#pragma unroll
            for (int cb = 0; cb < 4; ++cb) s[rb][cb] = (f32x4){0.f, 0.f, 0.f, 0.f};
#pragma unroll
        for (int ks = 0; ks < 4; ++ks)
#pragma unroll
            for (int cb = 0; cb < 4; ++cb) { const bf16x8 kf = *(const LAS bf16x8*)(kbuf + (cb * 16 + r16) * 272 + ks * 64 + q4 * 16);
#pragma unroll
                for (int rb = 0; rb < 2; ++rb) s[rb][cb] = MFMA16(qf[rb][ks], kf, s[rb][cb]); }
#pragma unroll
        for (int rb = 0; rb < 2; ++rb)
#pragma unroll
            for (int cb = 0; cb < 4; ++cb)
#pragma unroll
                for (int j = 0; j < 4; ++j) {
                    float p = exp2f(s[rb][cb][j] - mfix2);
                    if (masked) { const int dq = (q0 + rw0 + rb * 16 + q4 * 4 + j) - (p0 - CTXL + cb * 16 + r16); if (dq > 128 || dq < -128) p = 0.f; }
                    lsum[rb][j] += p;
                    *(LAS bf16_t*)(Pw + (rb * 16 + q4 * 4 + j) * 144 + (cb * 16 + r16) * 2) = f2bf1(p);
                }
        asm volatile("s_waitcnt lgkmcnt(0)" ::: "memory");
#pragma unroll
        for (int ks = 0; ks < 2; ++ks) { bf16x8 pf[2];
#pragma unroll
            for (int rb = 0; rb < 2; ++rb) pf[rb] = *(const LAS bf16x8*)(Pw + (rb * 16 + r16) * 144 + ks * 64 + q4 * 16);
#pragma unroll
            for (int db = 0; db < 8; ++db) { const bf16x8 vf = *(const LAS bf16x8*)(vbuf + (db * 16 + r16) * 144 + ks * 64 + q4 * 16);
#pragma unroll
                for (int rb = 0; rb < 2; ++rb) o[rb][db] = MFMA16(pf[rb], vf, o[rb][db]); } }
        }
        asm volatile("s_waitcnt lgkmcnt(0)" ::: "memory");

          if (i + 1 < ntiles) ATT_STORE(0, krB, vrB);
          __syncthreads(); }
    }
    LAS unsigned char* ob = lds + wave * 8704;
#pragma unroll
    for (int rb = 0; rb < 2; ++rb)
#pragma unroll
        for (int j = 0; j < 4; ++j) { float l = lsum[rb][j]; l += __shfl_xor(l, 1); l += __shfl_xor(l, 2); l += __shfl_xor(l, 4); l += __shfl_xor(l, 8);
            const float inv = 1.f / (l + psink);
#pragma unroll
            for (int db = 0; db < 8; ++db) *(LAS bf16_t*)(ob + (rb * 16 + q4 * 4 + j) * 272 + (db * 16 + r16) * 2) = f2bf1(o[rb][db][j] * inv); }
    asm volatile("s_waitcnt lgkmcnt(0)" ::: "memory");
#pragma unroll
    for (int i = 0; i < 8; ++i) { const int c = lane + 64 * i, row = c >> 4, seg = c & 15;
        *(u32x4*)(mix + (size_t)(b * SEQ + q0 + rw0 + row) * D + head * 128 + seg * 8) = *(const LAS u32x4*)(ob + row * 272 + seg * 16); }
    __syncthreads();
#undef ATT_POS0
#undef ATT_LOAD
#undef ATT_STORE
}

__device__ __forceinline__ void gla_scan_item(const Params& P, int item, LAS unsigned char* lds) {
    const int tid = threadIdx.x, lane = tid & 63, wave = __builtin_amdgcn_readfirstlane(tid >> 6), r16 = lane & 15, q4 = lane >> 4;
    const int es = item & 3, h = (item >> 2) & 3, b = (item >> 4) & 7, dir = item >> 7;
    const int ch = (dir * 8 + b) * 4 + h;
    const bf16_t* QE = (const bf16_t*)(P.ws + WS_QE); const bf16_t* KE = (const bf16_t*)(P.ws + WS_KE); const bf16_t* KDT = (const bf16_t*)(P.ws + WS_KDT);
    const float* DEC = (const float*)(P.ws + WS_DEC); const bf16_t* VT = (const bf16_t*)(P.ws + WS_VT) + ((size_t)((b * 4 + h) * 256 + es * 64)) * KVLEN;
    float* od = (float*)(P.ws + WS_X) + (size_t)dir * NTOK * 1024;
    LAS unsigned char* Al = lds;
    LAS unsigned char* ST0 = lds + 9216; LAS unsigned char* ST1 = ST0 + 17408;
    LAS unsigned char* Lq = lds + 44032;
    LAS unsigned char* Lk = Lq + 17408;
    LAS unsigned char* Ld = Lk + 17408;
    LAS unsigned char* Lv = Ld + 18432;
    for (int i = tid; i < 17408 / 4; i += 512) ((LAS unsigned*)ST0)[i] = 0u;
    f32x4 sreg[4];
#pragma unroll
    for (int eb = 0; eb < 4; ++eb) sreg[eb] = (f32x4){0.f, 0.f, 0.f, 0.f};
    const int cbk = wave >> 1, hb = (wave & 1) * 2;
    const int qrow = tid >> 4, qseg = tid & 15, drow = tid >> 3, dseg = tid & 7;
    u32x4 rq[2], rk[2], rd[2], rv; f32x4 decn;
#define GLA_PC(n) (dir ? ((n) < 4 ? 3 - (n) : 39 - (n)) : (n))
#define GLA_LOAD(n) do { const int _pc = GLA_PC(n); \
        if (_pc >= 4) { const bf16_t* _q = QE + ((size_t)ch * KVLEN + _pc * 64) * 128 + qseg * 8; const bf16_t* _k = KE + ((size_t)ch * KVLEN + _pc * 64) * 128 + qseg * 8; \
            rq[0] = *(const u32x4*)(_q + qrow * 128); rq[1] = *(const u32x4*)(_q + (qrow + 32) * 128); rk[0] = *(const u32x4*)(_k + qrow * 128); rk[1] = *(const u32x4*)(_k + (qrow + 32) * 128); } \
        const bf16_t* _d = KDT + ((size_t)ch * 36 + _pc) * 128 * 64 + dseg * 8; rd[0] = *(const u32x4*)(_d + drow * 64); rd[1] = *(const u32x4*)(_d + (drow + 64) * 64); \
        rv = *(const u32x4*)(VT + (size_t)drow * KVLEN + _pc * 64 + dseg * 8); \
        decn = *(const f32x4*)(DEC + ((size_t)ch * 36 + _pc) * 128 + wave * 16 + q4 * 4); } while (0)
#define GLA_STORE(n) do { const int _pc = GLA_PC(n); \
        if (_pc >= 4) { *(LAS u32x4*)(Lq + qrow * 272 + qseg * 16) = rq[0]; *(LAS u32x4*)(Lq + (qrow + 32) * 272 + qseg * 16) = rq[1]; \
                        *(LAS u32x4*)(Lk + qrow * 272 + qseg * 16) = rk[0]; *(LAS u32x4*)(Lk + (qrow + 32) * 272 + qseg * 16) = rk[1]; } \
        *(LAS u32x4*)(Ld + drow * 144 + dseg * 16) = rd[0]; *(LAS u32x4*)(Ld + (drow + 64) * 144 + dseg * 16) = rd[1]; *(LAS u32x4*)(Lv + drow * 144 + dseg * 16) = rv; } while (0)
    GLA_LOAD(0); GLA_STORE(0);
    f32x4 dec4 = decn;
    __syncthreads();
    for (int n = 0; n < 36; ++n) {
        const int pc = GLA_PC(n);
        LAS unsigned char* STc = (n & 1) ? ST1 : ST0; LAS unsigned char* STn = (n & 1) ? ST0 : ST1;
        if (n + 1 < 36) GLA_LOAD(n + 1);
        if (pc >= 4) {
            bf16x8 qf[4];
#pragma unroll
            for (int ks = 0; ks < 4; ++ks) qf[ks] = *(const LAS bf16x8*)(Lq + (cbk * 16 + r16) * 272 + ks * 64 + q4 * 16);
#pragma unroll
            for (int t2 = 0; t2 < 2; ++t2) { const int sbk = hb + t2;
                f32x4 a = (f32x4){0.f, 0.f, 0.f, 0.f};
#pragma unroll
                for (int ks = 0; ks < 4; ++ks) { const bf16x8 kf = *(const LAS bf16x8*)(Lk + (sbk * 16 + r16) * 272 + ks * 64 + q4 * 16); a = MFMA16(qf[ks], kf, a); }
#pragma unroll
                for (int j = 0; j < 4; ++j) { const int c = cbk * 16 + q4 * 4 + j, s_ = sbk * 16 + r16; const bool keep = dir ? (s_ >= c) : (s_ <= c);
                    *(LAS bf16_t*)(Al + c * 144 + s_ * 2) = f2bf1(keep ? a[j] : 0.f); } }
            __syncthreads();
#pragma unroll
            for (int t2 = 0; t2 < 2; ++t2) { const int ebk = hb + t2; f32x4 ov = (f32x4){0.f, 0.f, 0.f, 0.f};
#pragma unroll
                for (int ks = 0; ks < 2; ++ks) { const bf16x8 af = *(const LAS bf16x8*)(Al + (cbk * 16 + r16) * 144 + ks * 64 + q4 * 16);
                    const bf16x8 vfo = *(const LAS bf16x8*)(Lv + (ebk * 16 + r16) * 144 + ks * 64 + q4 * 16); ov = MFMA16(af, vfo, ov); }
#pragma unroll
                for (int ks = 0; ks < 4; ++ks) { const bf16x8 sf = *(const LAS bf16x8*)(STc + (ebk * 16 + r16) * 272 + ks * 64 + q4 * 16); ov = MFMA16(qf[ks], sf, ov); }
#pragma unroll
                for (int j = 0; j < 4; ++j) od[(size_t)(b * SEQ + (pc - 4) * 64 + cbk * 16 + q4 * 4 + j) * 1024 + h * 256 + es * 64 + ebk * 16 + r16] = ov[j]; }
        }
        { bf16x8 kdf[2];
#pragma unroll
          for (int ks = 0; ks < 2; ++ks) kdf[ks] = *(const LAS bf16x8*)(Ld + (wave * 16 + r16) * 144 + ks * 64 + q4 * 16);
#pragma unroll
          for (int eb = 0; eb < 4; ++eb) { f32x4 sv = sreg[eb] * dec4;
#pragma unroll
              for (int ks = 0; ks < 2; ++ks) { const bf16x8 vf = *(const LAS bf16x8*)(Lv + (eb * 16 + r16) * 144 + ks * 64 + q4 * 16); sv = MFMA16(kdf[ks], vf, sv); }
              sreg[eb] = sv;
              u32x2 w; w.x = cvt_pk_bf16(sv[0], sv[1]); w.y = cvt_pk_bf16(sv[2], sv[3]);
              *(LAS u32x2*)(STn + (eb * 16 + r16) * 272 + (wave * 16 + q4 * 4) * 2) = w; } }
        __syncthreads();
        if (n + 1 < 36) { GLA_STORE(n + 1); dec4 = decn; }
        __syncthreads();
    }
#undef GLA_PC
#undef GLA_LOAD
#undef GLA_STORE
}

__device__ __forceinline__ void gla_out_phase(const Params& P) {
    const int tid = threadIdx.x, lane = tid & 63, wave = tid >> 6;
    const bf16_t* proj = (const bf16_t*)(P.ws + WS_PROJ);
    const float* of = (const float*)(P.ws + WS_X); const float* ob = of + (size_t)NTOK * 1024;
    bf16_t* mix = (bf16_t*)(P.ws + WS_MIX);
    const f32x4 gn = *(const f32x4*)(P.in[18] + lane * 4);
    for (int idx = blockIdx.x * 8 + wave; idx < NTOK * 4; idx += gridDim.x * 8) {
        const int row = idx >> 2, h = idx & 3; const size_t off = (size_t)row * 1024 + h * 256 + lane * 4;
        const f32x4 o = *(const f32x4*)(of + off) + *(const f32x4*)(ob + off);
        const float ss = wave_sum((o[0] * o[0] + o[1] * o[1]) + (o[2] * o[2] + o[3] * o[3]));
        const float rstd = rsqrtf(ss * (1.f / 256.f) + 1e-6f);
        const u32x2 gw = *(const u32x2*)(proj + (size_t)row * INCP + C_BG + h * 256 + lane * 4);
        const float g0 = __uint_as_float(gw.x << 16), g1 = __uint_as_float(gw.x & 0xffff0000u), g2 = __uint_as_float(gw.y << 16), g3 = __uint_as_float(gw.y & 0xffff0000u);
        u32x2 w; w.x = cvt_pk_bf16(o[0] * rstd * gn[0] * silu_f(g0), o[1] * rstd * gn[1] * silu_f(g1)); w.y = cvt_pk_bf16(o[2] * rstd * gn[2] * silu_f(g2), o[3] * rstd * gn[3] * silu_f(g3));
        *(u32x2*)(mix + (size_t)row * D + 1024 + h * 256 + lane * 4) = w;
    }
}

__global__ void __launch_bounds__(512, 2) mega(Params P) {
    extern __shared__ __attribute__((aligned(16))) unsigned char smem[];
    LAS unsigned char* lds = (LAS unsigned char*)smem;
    cg::grid_group grid = cg::this_grid();
    unsigned char* ws = P.ws;
    float* mod = (float*)(ws + WS_MOD);
    bf16_t* x16 = (bf16_t*)(ws + WS_X);
    bf16_t* hbuf = (bf16_t*)(ws + WS_H);
    bf16_t* mix = (bf16_t*)(ws + WS_MIX);
#ifdef ONLY_PH
#define RUN_PH(ph) if ((ph) == ONLY_PH && P.ph_lo <= (ph) && (ph) < P.ph_hi)
#else
#define RUN_PH(ph) if (P.ph_lo <= (ph) && (ph) < P.ph_hi)
#endif
#define SYNC_PH(ph) do { if ((ph) > P.ph_lo && (ph) < P.ph_hi) xcd_barrier(xbar); } while (0)
    if (threadIdx.x < 16) ((LAS unsigned*)(lds + 131072))[threadIdx.x] = 0u;
    __syncthreads();
    XcdBarrier xbar = xcd_barrier_post((unsigned*)(ws + WS_BAR), (volatile LAS unsigned*)(lds + 131072));
    if (P.ph_lo < 0) grid.sync();
    const float* mod0 = mod; const float* mod1 = mod + (size_t)9 * 12288;
    RUN_PH(0) { ada_phase(P, lds); __syncthreads(); weights_phase(P, lds); }
    SYNC_PH(1);
    RUN_PH(1) norm_phase(P.in[0], P.in[2], NROWS, P.in[6], mod0, 0, 1, hbuf, (const bf16_t*)(ws + WS_WIN), (bf16_t*)(ws + WS_PROJ), nullptr, lds);
    SYNC_PH(2);
    RUN_PH(2) { GemmP g = gemm_std(hbuf, D, ws + WS_WIN, D, D, NTOK / 256, INCP / 256); g.extra = 64; g.out = ws + WS_PROJ; g.ldc = INCP; g.o_pm = (size_t)256 * INCP; gemm_phase(lds, g); }
    SYNC_PH(3);
    RUN_PH(3) prep_phase(P, lds);
    SYNC_PH(4);
    RUN_PH(4) {
        float gq = fmaxf(fabsf(P.in[11][threadIdx.x & 63]), fabsf(P.in[11][64 + (threadIdx.x & 63)])), gk = fmaxf(fabsf(P.in[12][threadIdx.x & 63]), fabsf(P.in[12][64 + (threadIdx.x & 63)]));
#pragma unroll
        for (int o = 1; o < 64; o <<= 1) { gq = fmaxf(gq, __shfl_xor(gq, o)); gk = fmaxf(gk, __shfl_xor(gk, o)); }
        const float mfix2 = 11.313708498984761f * gq * gk * LOG2E;
        for (int it = blockIdx.x; it < 512; it += gridDim.x) attn_item(P, it, lds, mfix2);
        for (int it = blockIdx.x; it < 256; it += gridDim.x) gla_scan_item(P, it, lds);
    }
    SYNC_PH(5);
    RUN_PH(5) gla_out_phase(P);
    SYNC_PH(6);
    RUN_PH(6) { GemmP g = gemm_std(mix, D, ws + WS_WOUT, D, D, NTOK / 256, D / 256); g.mode = 1; g.out = x16; g.out16 = 1; g.ldc = D; g.o_pm = (size_t)256 * D; g.base = P.in[0]; g.gate = mod0 + 2 * 2048; gemm_phase(lds, g); }
    SYNC_PH(7);
    RUN_PH(7) norm_phase(nullptr, nullptr, NTOK, P.in[7], mod0, 3, 4, hbuf, nullptr, nullptr, x16);
    SYNC_PH(8);
    RUN_PH(8) { GemmP g = gemm_std(hbuf, D, ws + WS_W1, D, D, NTOK / 256, DFF / 256); g.act = 1; g.out = ws + WS_HID; g.ldc = DFF; g.o_pm = (size_t)256 * DFF; gemm_phase(lds, g); }
    SYNC_PH(9);
    RUN_PH(9) { GemmP g = gemm_std(ws + WS_HID, DFF, ws + WS_W2, DFF, DFF, NTOK / 256, D / 256); g.mode = 1; g.out = x16; g.out16 = 1; g.ldc = D; g.o_pm = (size_t)256 * D; g.base = (const float*)x16; g.base16 = 1; g.gate = mod0 + 5 * 2048; gemm_phase(lds, g); }
    SYNC_PH(10);
    RUN_PH(10) norm_pair_phase(x16, P.in[6] + D, mod1, hbuf);
    SYNC_PH(11);
    RUN_PH(11) { GemmP g = gemm_std(ws + WS_CMA, 256, hbuf, D, 256, 2, 8); g.nB = 64; g.b_bs_hi = (size_t)SEQ * D * 2; g.b_bs_lo = 256 * 2; g.act = 2;
        g.out = ws + WS_GT; g.ldc = 2048; g.o_bs_hi = (size_t)2048 * 2048; g.o_bs_lo = (size_t)256 * 2048; g.o_pm = 0; gemm_phase(lds, g); }
    SYNC_PH(12);
    RUN_PH(12) { GemmP g = gemm_std(ws + WS_CN, 2048, ws + WS_GT, 2048, 2048, 8, 8); g.nB = 8; g.b_bs_lo = (size_t)2048 * 2048 * 2;
        g.out = mix; g.ldc = D; g.o_bs_lo = (size_t)SEQ * D; g.o_pm = (size_t)256 * D; g.scale = 0.0013810679320049757f; gemm_phase(lds, g); }
    SYNC_PH(13);
    RUN_PH(13) { GemmP g = gemm_std(mix, D, ws + WS_CW, D, D, NTOK / 256, D / 256); g.mode = 1; g.out = x16; g.out16 = 1; g.ldc = D; g.o_pm = (size_t)256 * D; g.base = (const float*)x16; g.base16 = 1; g.gate = mod1 + 2 * 2048; g.bias = P.in[21]; gemm_phase(lds, g); }
    SYNC_PH(14);
    RUN_PH(14) norm_phase(nullptr, nullptr, NTOK, P.in[7] + D, mod1, 3, 4, hbuf, nullptr, nullptr, x16);
    SYNC_PH(15);
    RUN_PH(15) { GemmP g = gemm_std(hbuf, D, ws + WS_W1 + (size_t)DFF * D * 2, D, D, NTOK / 256, DFF / 256); g.act = 1; g.out = ws + WS_HID; g.ldc = DFF; g.o_pm = (size_t)256 * DFF; gemm_phase(lds, g); }
    SYNC_PH(16);
    RUN_PH(16) { GemmP g = gemm_std(ws + WS_HID, DFF, ws + WS_W2 + (size_t)DFF * D * 2, DFF, DFF, NTOK / 256, D / 256); g.mode = 1; g.out = P.out; g.ldc = D; g.o_pm = (size_t)256 * D; g.base = (const float*)x16; g.base16 = 1; g.gate = mod1 + 5 * 2048; gemm_phase(lds, g); }
}

extern "C" void kernel_launch(void* const* d_in, const int* in_sizes, int n_in, void* d_out, int out_size, void* d_ws, size_t ws_size, hipStream_t stream) {
    static int grid = 0;
    if (grid == 0) {
        if (n_in != 22 || out_size != NTOK * D || ws_size < WS_TOTAL) { fprintf(stderr, "kernel_launch: unexpected shapes (n_in %d, out %d, ws %zu < %zu)\n", n_in, out_size, ws_size, (size_t)WS_TOTAL); grid = -1; return; }
        int dev = 0, cus = 0, per_cu = 0;
        hipGetDevice(&dev); hipDeviceGetAttribute(&cus, hipDeviceAttributeMultiprocessorCount, dev);
        if (hipFuncSetAttribute((const void*)mega, hipFuncAttributeMaxDynamicSharedMemorySize, LDS_BYTES) != hipSuccess) { fprintf(stderr, "kernel_launch: hipFuncSetAttribute failed\n"); grid = -1; return; }
        if (hipOccupancyMaxActiveBlocksPerMultiprocessor(&per_cu, (const void*)mega, 512, LDS_BYTES) != hipSuccess || per_cu < 1) { fprintf(stderr, "kernel_launch: occupancy query failed (%d)\n", per_cu); per_cu = 1; (void)hipGetLastError(); }
        grid = cus * 1;
        if (grid % 8 != 0 || grid < 64) { fprintf(stderr, "kernel_launch: unexpected CU count %d\n", cus); }
    }
    if (grid < 0) return;
    if (hipMemsetAsync((char*)d_ws + WS_BAR, 0, XCD_BAR_WORDS * 4, stream) != hipSuccess) { fprintf(stderr, "kernel_launch: memset of barrier words failed\n"); return; }
    Params p{};
    for (int i = 0; i < 22; ++i) p.in[i] = (const float*)d_in[i];
    p.out = (float*)d_out; p.ws = (unsigned char*)d_ws; p.ph_lo = 0; p.ph_hi = NPH;
    void* args[] = {&p};
    hipError_t e = hipLaunchCooperativeKernel((const void*)mega, dim3(grid), dim3(512), args, LDS_BYTES, stream);
    if (e != hipSuccess) fprintf(stderr, "cooperative launch failed: %s (grid %d)\n", hipGetErrorString(e), grid);
}
```
